# Optimizing an MI355X kernel written in HIP

```python
import math
import jax, jax.numpy as jnp
from jax import lax
import numpy as np

D_MODEL = 1024
BATCH = 8
SEQ = 4096
DEPTH = 1
DEC_BATCH = 8
DEC_SEQ = 64
PAST_LEN = 4096

CHUNK = 64
HEAD_DIM = 64
SSM_WIDTH = D_MODEL // 2
SSM_HEADS = SSM_WIDTH // HEAD_DIM
SSM_GROUPS = 2
D_STATE = 128
CONV_W = 4
CONV_DIM = SSM_WIDTH + 2 * SSM_GROUPS * D_STATE
ATTN_WIDTH = D_MODEL - SSM_WIDTH
ATTN_HEADS = ATTN_WIDTH // HEAD_DIM
KV_HEADS = 2
Q_PER_KV = ATTN_HEADS // KV_HEADS
WINDOW = 128
WIN_CHUNKS = WINDOW // CHUNK
D_FF = 256 * math.ceil(8 * D_MODEL / (3 * 256))
IN_COLS = SSM_WIDTH + CONV_DIM + SSM_HEADS + ATTN_WIDTH + 2 * KV_HEADS * HEAD_DIM
V_COL_START = IN_COLS - KV_HEADS * HEAD_DIM
LN_EPS = 1e-5
RMS_EPS = 1e-5
DEEPNORM_ALPHA = (2.0 * DEPTH) ** 0.25
DEEPNORM_BETA = (8.0 * DEPTH) ** -0.25

kernel_name = 'hymba_ssd_swa_sink_alibi_deepnorm_stream_step'


def in_proj_split_points():
    sizes = [SSM_WIDTH, CONV_DIM, SSM_HEADS, ATTN_WIDTH, KV_HEADS * HEAD_DIM]
    return [int(s) for s in np.cumsum(sizes)]


def alibi_slopes():
    return jnp.exp2(-8.0 * jnp.arange(1, ATTN_HEADS + 1, dtype=jnp.float32) / ATTN_HEADS)


def layer_norm(x, g, b):
    xf = x.astype(jnp.float32)
    mu = jnp.mean(xf, axis=-1, keepdims=True)
    var = jnp.mean(jnp.square(xf - mu), axis=-1, keepdims=True)
    out = (xf - mu) * lax.rsqrt(var + LN_EPS) * g.astype(jnp.float32) + b.astype(jnp.float32)
    return out.astype(x.dtype)


def gated_rms_norm(y, z, w):
    g = y * jax.nn.silu(z.astype(jnp.float32))
    g = g.reshape(*g.shape[:-1], SSM_GROUPS, SSM_WIDTH // SSM_GROUPS)
    g = g * lax.rsqrt(jnp.mean(jnp.square(g), axis=-1, keepdims=True) + RMS_EPS)
    return g.reshape(*y.shape) * w.astype(jnp.float32)


def ssd_scan(xs, dt, a, bm, cm, s0):
    bsz, seq = xs.shape[:2]
    cl = min(CHUNK, seq)
    nc = seq // cl
    r = SSM_HEADS // SSM_GROUPS
    xdt = (xs * dt[..., None]).reshape(bsz, nc, cl, SSM_GROUPS, r, HEAD_DIM)
    cum = jnp.cumsum((dt * a).reshape(bsz, nc, cl, SSM_GROUPS, r), axis=2)
    bm = bm.reshape(bsz, nc, cl, SSM_GROUPS, D_STATE)
    cm = cm.reshape(bsz, nc, cl, SSM_GROUPS, D_STATE)
    seg = cum[:, :, :, None] - cum[:, :, None, :]
    causal = jnp.tril(jnp.ones((cl, cl), dtype=bool))[:, :, None, None]
    decay = jnp.exp(jnp.where(causal, seg, -jnp.inf))
    cb = jnp.einsum('bclgn,bcsgn->bclsg', cm, bm)
    y_diag = jnp.einsum('bclsgr,bcsgrp->bclgrp', cb[..., None] * decay, xdt)
    to_end = jnp.exp(cum[:, :, -1:] - cum)
    block_states = jnp.einsum('bclgn,bclgrp->bcgrpn', bm, xdt * to_end[..., None])
    block_decay = jnp.exp(cum[:, :, -1])

    def carry_step(s, inp):
        st, dec = inp
        return dec[..., None, None] * s + st, s

    s_final, s_prev = lax.scan(
        carry_step, s0.reshape(bsz, SSM_GROUPS, r, HEAD_DIM, D_STATE),
        (jnp.moveaxis(block_states, 1, 0), jnp.moveaxis(block_decay, 1, 0)))
    s_prev = jnp.moveaxis(s_prev, 0, 1)
    y_off = jnp.einsum('bclgn,bcgrpn->bclgrp', cm, s_prev) * jnp.exp(cum)[..., None]
    y = (y_diag + y_off).reshape(bsz, seq, SSM_HEADS, HEAD_DIM)
    return y, s_final.reshape(bsz, SSM_HEADS, HEAD_DIM, D_STATE)


def sink_attention(q, k, v, dist, valid, slopes, sinks):
    f32 = jnp.float32
    s = jnp.einsum('...qgrd,...sgd->...grqs', q.astype(f32), k.astype(f32)) * (HEAD_DIM ** -0.5)
    s = s - slopes.reshape(KV_HEADS, Q_PER_KV, 1, 1) * dist
    s = jnp.where(valid, s, -jnp.inf)
    sink = sinks.astype(f32).reshape(KV_HEADS, Q_PER_KV, 1, 1)
    m = jnp.maximum(jnp.max(s, axis=-1, keepdims=True), sink)
    p = jnp.exp(s - m)
    denom = jnp.sum(p, axis=-1, keepdims=True) + jnp.exp(sink - m)
    return jnp.einsum('...grqs,...sgd->...qgrd', p / denom, v.astype(f32))


def band_attention(q, k, v, slopes, sinks):
    bsz, seq = q.shape[:2]
    nc = seq // CHUNK
    band = (WIN_CHUNKS + 1) * CHUNK
    qc = q.reshape(bsz, nc, CHUNK, KV_HEADS, Q_PER_KV, HEAD_DIM)

    def banded(t):
        tp = jnp.pad(t, ((0, 0), (WIN_CHUNKS * CHUNK, 0), (0, 0), (0, 0)))
        tp = tp.reshape(bsz, nc + WIN_CHUNKS, CHUNK, KV_HEADS, HEAD_DIM)
        return jnp.concatenate([tp[:, j:j + nc] for j in range(WIN_CHUNKS + 1)], axis=2)

    kb, vb = banded(k), banded(v)
    qi = jnp.arange(CHUNK)[:, None] + WIN_CHUNKS * CHUNK
    kj = jnp.arange(band)[None, :]
    dist = jnp.abs(qi - kj).astype(jnp.float32)
    key_chunk = jnp.arange(nc)[:, None] - WIN_CHUNKS + kj // CHUNK
    valid = (key_chunk >= 0)[:, None, None, None, :]
    return sink_attention(qc, kb, vb, dist, valid, slopes, sinks)


def window_step_attention(q, kk, vv, slopes, sinks):
    t = q.shape[1]
    dist = jnp.abs(jnp.arange(t)[:, None] + WINDOW - jnp.arange(WINDOW + t)[None, :]).astype(jnp.float32)
    valid = jnp.ones((t, WINDOW + t), dtype=bool)
    return sink_attention(q, kk, vv, dist, valid, slopes, sinks)


def token_mixers(x, conv_hist, ssm_state, win_k, win_v, slopes, w_in, conv_w, conv_b, dt_bias, a_log,
                 d_skip, ssm_norm_w, attn_sinks, w_out):
    f32 = jnp.float32
    bsz, seq = x.shape[:2]
    proj = jnp.einsum('bld,de->ble', x, w_in)
    z, xbc, dt_raw, q, k, v = jnp.split(proj, in_proj_split_points(), axis=-1)
    xbc_hist = jnp.concatenate([conv_hist.astype(xbc.dtype), xbc], axis=1)
    conv = conv_b
    for i in range(CONV_W):
        conv = conv + conv_w[i] * xbc_hist[:, i:i + seq]
    xbc = jax.nn.silu(conv)
    new_conv = xbc_hist[:, -(CONV_W - 1):]
    xs, bm, cm = jnp.split(xbc.astype(f32), [SSM_WIDTH, SSM_WIDTH + SSM_GROUPS * D_STATE], axis=-1)
    xs = xs.reshape(bsz, seq, SSM_HEADS, HEAD_DIM)
    dt = jax.nn.softplus(dt_raw.astype(f32) + dt_bias.astype(f32))
    a = -jnp.exp(a_log.astype(f32))
    y, new_ssm = ssd_scan(xs, dt, a, bm.reshape(bsz, seq, SSM_GROUPS, D_STATE),
                          cm.reshape(bsz, seq, SSM_GROUPS, D_STATE), ssm_state.astype(f32))
    y = y + d_skip.astype(f32)[:, None] * xs
    y = gated_rms_norm(y.reshape(bsz, seq, SSM_WIDTH), z, ssm_norm_w)
    q = q.reshape(bsz, seq, KV_HEADS, Q_PER_KV, HEAD_DIM)
    k = k.reshape(bsz, seq, KV_HEADS, HEAD_DIM)
    v = v.reshape(bsz, seq, KV_HEADS, HEAD_DIM)
    if win_k is None:
        o = band_attention(q, k, v, slopes, attn_sinks)
        new_k, new_v = k[:, -WINDOW:], v[:, -WINDOW:]
    else:
        kk = jnp.concatenate([win_k.astype(k.dtype), k], axis=1)
        vv = jnp.concatenate([win_v.astype(v.dtype), v], axis=1)
        o = window_step_attention(q, kk, vv, slopes, attn_sinks)
        new_k, new_v = kk[:, -WINDOW:], vv[:, -WINDOW:]
    o = o.reshape(bsz, seq, ATTN_WIDTH)
    mixed = jnp.concatenate([y.astype(x.dtype), o.astype(x.dtype)], axis=-1)
    out = jnp.einsum('ble,ed->bld', mixed, w_out)
    return out, new_conv, new_ssm, new_k, new_v


def swiglu(h, w_gate, w_up, w_down):
    g = jnp.einsum('bld,df->blf', h, w_gate)
    u = jnp.einsum('bld,df->blf', h, w_up)
    return jnp.einsum('blf,fd->bld', jax.nn.silu(g) * u, w_down)


def trunk_layer(x, conv_hist, ssm_state, win_k, win_v, slopes, w_in, conv_w, conv_b, dt_bias, a_log,
                d_skip, ssm_norm_w, attn_sinks, w_out, ln1_g, ln1_b, w_gate, w_up, w_down, ln2_g, ln2_b):
    mix, new_conv, new_ssm, new_k, new_v = token_mixers(
        x, conv_hist, ssm_state, win_k, win_v, slopes, w_in, conv_w, conv_b, dt_bias, a_log,
        d_skip, ssm_norm_w, attn_sinks, w_out)
    h = layer_norm(DEEPNORM_ALPHA * x + mix, ln1_g, ln1_b)
    y = layer_norm(DEEPNORM_ALPHA * h + swiglu(h, w_gate, w_up, w_down), ln2_g, ln2_b)
    return y, new_conv, new_ssm, new_k, new_v


def setup_inputs(seed: int = 0) -> dict:
    key = jax.random.key(seed)
    ks = jax.random.split(key, 24)
    f32 = jnp.float32

    def nrm(k, shape, scale):
        return scale * jax.random.normal(k, shape, f32)

    x_prompt = nrm(ks[0], (BATCH, SEQ, D_MODEL), 1.0)
    x_sample = nrm(ks[1], (DEC_BATCH, DEC_SEQ, D_MODEL), 1.0)
    state_conv = nrm(ks[2], (DEPTH, DEC_BATCH, CONV_W - 1, CONV_DIM), 1.0)
    state_ssm = nrm(ks[3], (DEPTH, DEC_BATCH, SSM_HEADS, HEAD_DIM, D_STATE), 0.1)
    cache_k = nrm(ks[4], (DEPTH, DEC_BATCH, WINDOW, KV_HEADS, HEAD_DIM), 1.0)
    cache_v = nrm(ks[5], (DEPTH, DEC_BATCH, WINDOW, KV_HEADS, HEAD_DIM), 1.0)
    w_in = nrm(ks[6], (DEPTH, D_MODEL, IN_COLS), D_MODEL ** -0.5)
    w_in = w_in * jnp.where(jnp.arange(IN_COLS) >= V_COL_START, DEEPNORM_BETA, 1.0).astype(f32)
    conv_w = nrm(ks[7], (DEPTH, CONV_W, CONV_DIM), CONV_W ** -0.5)
    conv_b = nrm(ks[8], (DEPTH, CONV_DIM), 0.01)
    dt0 = jnp.exp(jax.random.uniform(ks[9], (DEPTH, SSM_HEADS), f32, math.log(1e-3), math.log(1e-1)))
    dt_bias = dt0 + jnp.log(-jnp.expm1(-dt0))
    a_log = jnp.log(jax.random.uniform(ks[10], (DEPTH, SSM_HEADS), f32, 1.0, 16.0))
    d_skip = 1.0 + nrm(ks[11], (DEPTH, SSM_HEADS), 0.1)
    ssm_norm_w = 1.0 + nrm(ks[12], (DEPTH, SSM_WIDTH), 0.02)
    attn_sinks = nrm(ks[13], (DEPTH, ATTN_HEADS), 0.5)
    w_out = nrm(ks[14], (DEPTH, D_MODEL, D_MODEL), DEEPNORM_BETA * D_MODEL ** -0.5)
    ln1_g = 1.0 + nrm(ks[15], (DEPTH, D_MODEL), 0.02)
    ln1_b = nrm(ks[16], (DEPTH, D_MODEL), 0.02)
    w_gate = nrm(ks[17], (DEPTH, D_MODEL, D_FF), D_MODEL ** -0.5)
    w_up = nrm(ks[18], (DEPTH, D_MODEL, D_FF), D_MODEL ** -0.5)
    w_down = nrm(ks[19], (DEPTH, D_FF, D_MODEL), DEEPNORM_BETA * D_FF ** -0.5)
    ln2_g = 1.0 + nrm(ks[20], (DEPTH, D_MODEL), 0.02)
    ln2_b = nrm(ks[21], (DEPTH, D_MODEL), 0.02)
    return {'x_prompt': x_prompt, 'x_sample': x_sample, 'state_conv': state_conv, 'state_ssm': state_ssm,
            'cache_k': cache_k, 'cache_v': cache_v, 'w_in': w_in, 'conv_w': conv_w, 'conv_b': conv_b,
            'dt_bias': dt_bias, 'a_log': a_log, 'd_skip': d_skip, 'ssm_norm_w': ssm_norm_w,
            'attn_sinks': attn_sinks, 'w_out': w_out, 'ln1_g': ln1_g, 'ln1_b': ln1_b, 'w_gate': w_gate,
            'w_up': w_up, 'w_down': w_down, 'ln2_g': ln2_g, 'ln2_b': ln2_b}


def reference(x_prompt, x_sample, state_conv, state_ssm, cache_k, cache_v, w_in, conv_w, conv_b, dt_bias,
              a_log, d_skip, ssm_norm_w, attn_sinks, w_out, ln1_g, ln1_b, w_gate, w_up, w_down, ln2_g, ln2_b):
    slopes = alibi_slopes()
    bsz = x_prompt.shape[0]
    h_p, h_s = x_prompt, x_sample
    new_p, new_s = [], []
    for layer in range(DEPTH):
        lw = (w_in[layer], conv_w[layer], conv_b[layer], dt_bias[layer], a_log[layer], d_skip[layer],
              ssm_norm_w[layer], attn_sinks[layer], w_out[layer], ln1_g[layer], ln1_b[layer],
              w_gate[layer], w_up[layer], w_down[layer], ln2_g[layer], ln2_b[layer])
        zero_conv = jnp.zeros((bsz, CONV_W - 1, CONV_DIM), x_prompt.dtype)
        zero_ssm = jnp.zeros((bsz, SSM_HEADS, HEAD_DIM, D_STATE), jnp.float32)
        h_p, *st_p = trunk_layer(h_p, zero_conv, zero_ssm, None, None, slopes, *lw)
        h_s, *st_s = trunk_layer(h_s, state_conv[layer], state_ssm[layer], cache_k[layer], cache_v[layer],
                                 slopes, *lw)
        new_p.append(st_p)
        new_s.append(st_s)
    conv_p = jnp.stack([s[0] for s in new_p])
    ssm_p = jnp.stack([s[1] for s in new_p])
    k_p = jnp.stack([s[2] for s in new_p])
    v_p = jnp.stack([s[3] for s in new_p])
    conv_s = jnp.stack([s[0] for s in new_s])
    ssm_s = jnp.stack([s[1] for s in new_s])
    k_s = jnp.stack([s[2] for s in new_s])
    v_s = jnp.stack([s[3] for s in new_s])
    return (h_p, h_s, conv_p, ssm_p, k_p, v_p, conv_s, ssm_s, k_s, v_s)
```

```cpp
#include <hip/hip_runtime.h>
#include <hip/hip_cooperative_groups.h>
#include <cstdio>
#include <cstdint>
namespace cg = cooperative_groups;
namespace pg8 {
#define PG8_LAS __attribute__((address_space(3)))
typedef unsigned short bf16_t;
typedef short bf16x8 __attribute__((ext_vector_type(8)));
typedef float f32x4 __attribute__((ext_vector_type(4)));
typedef unsigned u32x4 __attribute__((ext_vector_type(4)));
constexpr int BM = 256, BK = 64, HALF = 128, HTB = HALF * BK * 2  , STAGE_BYTES = 8 * HTB, NXCD = 8, WGM = 8;

__host__ __device__ __forceinline__ int lds_byte(int r, int c) { const int st = (r >> 4) * 2 + (c >> 5), rr = r & 15, cc = c & 31, ob = rr * 64 + cc * 2; return st * 1024 + (ob ^ (((ob >> 9) & 1) << 5)); }
__host__ __device__ __forceinline__ void stage_rc(int b, int& R, int& C) { const int st = b / 1024, sb = b % 1024, swz = sb ^ (((sb >> 9) & 1) << 5); R = (st >> 1) * 16 + swz / 64; C = (st & 1) * 32 + (swz % 64) / 2; }
__host__ __device__ __forceinline__ int perm32(int rho) { const int n = rho >> 4, i = rho & 15; return 8 * (i >> 2) + 4 * n + (i & 3); }

struct Unit { int pm, pn; };
struct Gemm { const bf16_t* A; const bf16_t* Bt; int M, N, K; };

struct StaticOrder {
    int nM, nN, nwg, G, c;
    __host__ __device__ void init(int M, int N, int G_, int c_) { nM = M / BM; nN = N / BM; nwg = nM * nN; G = G_; c = c_; }
    __host__ __device__ bool next(int i, Unit& u) const {
        const long L = (long)i * G + c; if (L >= nwg) return false;
        int wgid = (int)L; { const int q = nwg / NXCD, r = nwg % NXCD, xcd = wgid % NXCD, off = wgid / NXCD; wgid = (xcd < r ? xcd * (q + 1) : r * (q + 1) + (xcd - r) * q) + off; }
        const int nig = WGM * nN, gid = wgid / nig, fm = gid * WGM, gsz = (nM - fm) < WGM ? (nM - fm) : WGM;
        u.pm = fm + ((wgid % nig) % gsz); u.pn = (wgid % nig) / gsz; return true;
    }
    __device__ __forceinline__ void a_ready(const Unit&) const {}
    __device__ __forceinline__ void done(const Unit&) const {}
};

__device__ __forceinline__ unsigned cvt_pk_bf16(float lo, float hi) { unsigned r; asm volatile("v_cvt_pk_bf16_f32 %0, %1, %2" : "=v"(r) : "v"(lo), "v"(hi)); return r; }
typedef float f32x2 __attribute__((ext_vector_type(2)));
__device__ __forceinline__ f32x2 gelu_pk(f32x2 v) {
    const f32x2 av = __builtin_elementwise_abs(v), d = av * 0.2316418882f + 1.0f;
    f32x2 t; t.x = __builtin_amdgcn_rcpf(d.x); t.y = __builtin_amdgcn_rcpf(d.y);
    f32x2 q = t * 0.5307027145f + (-0.7265760135f); q = q * t + 0.7107068705f; q = q * t + (-0.142248368f); q = q * t + 0.127414796f; q = q * t;
    const f32x2 s = (v * v) * (-0.72134752044f);
    f32x2 e; e.x = __builtin_amdgcn_exp2f(s.x); e.y = __builtin_amdgcn_exp2f(s.y);
    const f32x2 m = v * (q * e), r = v - m;
    f32x2 o; o.x = v.x < 0.f ? m.x : r.x; o.y = v.y < 0.f ? m.y : r.y; return o;
}

template <int ACT  > struct EpiBf16 {
    static constexpr bool PERM = true, AFTER_DRAIN = false; static_assert(ACT == 0 || ACT == 1, "EpiBf16: ACT is 0 (none) or 1 (gelu_pk)");
    bf16_t* O; int ldc; const float* bias; int split_cols; size_t split_stride; float scale0;
    __device__ __forceinline__ void operator()(const f32x4 (&acc)[2][2][4][2], const Unit& u, int wr, int wc, int fr, int fq) const {
        const int row0 = u.pm * BM + wr * 64 + fr; int colt = u.pn * BM; bf16_t* base = O;
        float sc = 1.f; if (split_cols) { const int t = colt / split_cols; base += (size_t)t * split_stride; colt -= t * split_cols; if (t == 0) sc = scale0; }
        const int col0 = colt + wc * 32 + 8 * fq, bcol0 = u.pn * BM + wc * 32 + 8 * fq;
        f32x4 bv[2][2];
#pragma unroll
        for (int bj = 0; bj < 2; ++bj)
#pragma unroll
            for (int n = 0; n < 2; ++n) bv[bj][n] = bias ? *(const f32x4*)(bias + bcol0 + bj * HALF + 4 * n) : (f32x4){0.f, 0.f, 0.f, 0.f};
#pragma unroll
        for (int ai = 0; ai < 2; ++ai)
#pragma unroll
            for (int m = 0; m < 4; ++m) { bf16_t* rowp = base + (size_t)(row0 + ai * HALF + m * 16) * ldc + col0;
#pragma unroll
                for (int bj = 0; bj < 2; ++bj) { f32x4 v0 = acc[ai][bj][m][0] + bv[bj][0], v1 = acc[ai][bj][m][1] + bv[bj][1];
                    if (ACT == 1) { f32x2 a = gelu_pk((f32x2){v0[0], v0[1]}), b = gelu_pk((f32x2){v0[2], v0[3]}), c = gelu_pk((f32x2){v1[0], v1[1]}), d = gelu_pk((f32x2){v1[2], v1[3]});
                        v0 = (f32x4){a.x, a.y, b.x, b.y}; v1 = (f32x4){c.x, c.y, d.x, d.y}; }
                    v0 = v0 * sc; v1 = v1 * sc; u32x4 w; w.x = cvt_pk_bf16(v0[0], v0[1]); w.y = cvt_pk_bf16(v0[2], v0[3]); w.z = cvt_pk_bf16(v1[0], v1[1]); w.w = cvt_pk_bf16(v1[2], v1[3]);
                    *(u32x4*)(rowp + bj * HALF) = w; } }
    }
};
template <class Epi, class Sched, bool ALIGN_EPI = false, bool SP2 = false>
__device__ __forceinline__ void gemm_phase(PG8_LAS unsigned char* lds, const Gemm g, const Sched& S, const Epi& E) {
    int tid_o = threadIdx.x; asm volatile("" : "+v"(tid_o));
    const int tid = tid_o, wid = __builtin_amdgcn_readfirstlane(tid >> 6), lane = tid & 63, wr = wid >> 2, wc = wid & 3, fr = lane & 15, fq = lane >> 4;
    const int K = g.K, nt = K / BK;
    unsigned voffA[2], voffB[2];
#pragma unroll
    for (int i = 0; i < 2; ++i) { int R, C; stage_rc(tid * 16 + i * 8192, R, C); const int Rb = Epi::PERM ? ((R & ~31) + perm32(R & 31)) : R;
        voffA[i] = (unsigned)(R * K + C) * 2u; voffB[i] = (unsigned)(Rb * K + C) * 2u; }
    const size_t kstep = (size_t)(BK * 2);
    const size_t hstep = (size_t)HALF * K * 2;
    const size_t tstep = 2 * hstep;
    const unsigned ldsw = (unsigned)wid * 1024u;
    const int aoff = lds_byte(wr * 64 + fr, fq * 8), boff = lds_byte(wc * 32 + fr, fq * 8);
#define PG8_SA(b, h) (((b) * 2 + (h)) * HTB)
#define PG8_SB(b, h) ((4 + (b) * 2 + (h)) * HTB)
#define PG8_STAGE(bufoff, gbase, voff) do { _Pragma("unroll") for (int _i = 0; _i < 2; ++_i) \
        __builtin_amdgcn_global_load_lds((const unsigned*)((const char*)(gbase) + (voff)[_i]), (PG8_LAS unsigned*)(lds + (bufoff) + ldsw + _i * 8192), 16, 0, 0); } while (0)
#define PG8_LDA(dst, b, h) do { _Pragma("unroll") for (int m = 0; m < 4; ++m) _Pragma("unroll") for (int k = 0; k < 2; ++k) dst[m][k] = *(const PG8_LAS bf16x8*)(lds + PG8_SA(b, h) + aoff + m * 2048 + k * 1024); } while (0)
#define PG8_LDB(dst, b, h) do { _Pragma("unroll") for (int n = 0; n < 2; ++n) _Pragma("unroll") for (int k = 0; k < 2; ++k) dst[n][k] = *(const PG8_LAS bf16x8*)(lds + PG8_SB(b, h) + boff + n * 2048 + k * 1024); } while (0)
#define PG8_MMA(ai, bj, At, Bt) do { __builtin_amdgcn_s_setprio(1); _Pragma("unroll") for (int m = 0; m < 4; ++m) _Pragma("unroll") for (int n = 0; n < 2; ++n) _Pragma("unroll") for (int k = 0; k < 2; ++k) \
        acc[ai][bj][m][n] = __builtin_amdgcn_mfma_f32_16x16x32_bf16(Bt[n][k], At[m][k], acc[ai][bj][m][n], 0, 0, 0); __builtin_amdgcn_s_setprio(0); } while (0)
#define PG8_WAIT_V(n) asm volatile("s_waitcnt vmcnt(" #n ")" ::: "memory")
#define PG8_WAIT_L(n) asm volatile("s_waitcnt lgkmcnt(" #n ")" ::: "memory")
#define PG8_BAR __builtin_amdgcn_s_barrier()
#define PG8_SCHED __builtin_amdgcn_sched_barrier(0)
    Unit cur, nxt; int ui = 0;
    if (!S.next(0, cur)) return;
    f32x4 acc[2][2][4][2];
#pragma unroll
    for (int a = 0; a < 2; ++a)
#pragma unroll
        for (int b = 0; b < 2; ++b)
#pragma unroll
            for (int m = 0; m < 4; ++m)
#pragma unroll
                for (int n = 0; n < 2; ++n) acc[a][b][m][n] = (f32x4){0.f, 0.f, 0.f, 0.f};
    bf16x8 At[4][2], B0[2][2], B1[2][2];
    const char* cA = (const char*)g.A + (size_t)cur.pm * tstep; const char* cB = (const char*)g.Bt + (size_t)cur.pn * tstep;
    S.a_ready(cur);
    if constexpr (SP2) {
        PG8_STAGE(PG8_SB(0, 0), cB, voffB); PG8_STAGE(PG8_SB(0, 1), cB + hstep, voffB); PG8_STAGE(PG8_SA(0, 0), cA, voffA); PG8_STAGE(PG8_SA(0, 1), cA + hstep, voffA);
        if (wr == 1) PG8_BAR;
        PG8_WAIT_V(2); PG8_BAR;
        PG8_STAGE(PG8_SB(1, 0), cB + kstep, voffB); PG8_STAGE(PG8_SA(1, 0), cA + kstep, voffA); PG8_STAGE(PG8_SB(1, 1), cB + hstep + kstep, voffB);
        PG8_WAIT_V(6); PG8_BAR;
    } else {
        PG8_STAGE(PG8_SB(0, 0), cB, voffB); PG8_STAGE(PG8_SA(0, 0), cA, voffA); PG8_STAGE(PG8_SB(0, 1), cB + hstep, voffB); PG8_STAGE(PG8_SA(0, 1), cA + hstep, voffA);
        if (wr == 1) PG8_BAR;
        PG8_WAIT_V(4); PG8_BAR;
        PG8_STAGE(PG8_SB(1, 0), cB + kstep, voffB); PG8_STAGE(PG8_SA(1, 0), cA + kstep, voffA); PG8_STAGE(PG8_SB(1, 1), cB + hstep + kstep, voffB);
        PG8_WAIT_V(6); PG8_BAR;
    }
    for (;;) {
        const bool has_next = S.next(ui + 1, nxt);
        const char* nA = has_next ? (const char*)g.A + (size_t)nxt.pm * tstep : cA; const char* nB = has_next ? (const char*)g.Bt + (size_t)nxt.pn * tstep : cB;
        for (int t = 0; t < nt; t += 2) {
            const bool last = (t == nt - 2);
            const char* a1 = cA + (size_t)(t + 1) * kstep;
            const char* a2 = last ? nA : cA + (size_t)(t + 2) * kstep; const char* b2 = last ? nB : cB + (size_t)(t + 2) * kstep;
            const char* a3 = a2 + kstep; const char* b3 = b2 + kstep;
            if (last && has_next) S.a_ready(nxt);
            if constexpr (SP2) {
            PG8_LDB(B0, 0, 0); PG8_LDB(B1, 0, 1); PG8_SCHED; PG8_LDA(At, 0, 0); PG8_STAGE(PG8_SA(1, 1), a1 + hstep, voffA);
            PG8_WAIT_V(8); PG8_WAIT_L(0); PG8_BAR; PG8_MMA(0, 0, At, B0); PG8_MMA(0, 1, At, B1); PG8_BAR; PG8_SCHED;
            PG8_LDA(At, 0, 1); PG8_STAGE(PG8_SB(0, 0), b2, voffB); PG8_STAGE(PG8_SB(0, 1), b2 + hstep, voffB); PG8_STAGE(PG8_SA(0, 0), a2, voffA);
            PG8_WAIT_V(8); PG8_WAIT_L(0); PG8_BAR; PG8_MMA(1, 0, At, B0); PG8_MMA(1, 1, At, B1); PG8_BAR; PG8_SCHED;
            PG8_LDB(B0, 1, 0); PG8_LDB(B1, 1, 1); PG8_SCHED; PG8_LDA(At, 1, 0); PG8_STAGE(PG8_SA(0, 1), a2 + hstep, voffA);
            PG8_WAIT_V(8); PG8_WAIT_L(0); PG8_BAR; PG8_MMA(0, 0, At, B0); PG8_MMA(0, 1, At, B1); PG8_BAR; PG8_SCHED;
            PG8_LDA(At, 1, 1); PG8_STAGE(PG8_SB(1, 0), b3, voffB); PG8_STAGE(PG8_SB(1, 1), b3 + hstep, voffB); PG8_STAGE(PG8_SA(1, 0), a3, voffA);
            PG8_WAIT_V(8); PG8_WAIT_L(0); PG8_BAR; PG8_MMA(1, 0, At, B0); PG8_MMA(1, 1, At, B1); PG8_BAR; PG8_SCHED;
            } else {
            PG8_LDB(B0, 0, 0); PG8_SCHED; PG8_LDA(At, 0, 0); PG8_STAGE(PG8_SA(1, 1), a1 + hstep, voffA);
            PG8_WAIT_L(8); PG8_BAR; PG8_WAIT_L(0); PG8_MMA(0, 0, At, B0); PG8_BAR; PG8_SCHED;
            PG8_LDB(B1, 0, 1); PG8_STAGE(PG8_SB(0, 0), b2, voffB);
            PG8_BAR; PG8_WAIT_L(0); PG8_MMA(0, 1, At, B1); PG8_BAR;
            PG8_LDA(At, 0, 1); PG8_STAGE(PG8_SA(0, 0), a2, voffA);
            PG8_BAR; PG8_WAIT_L(0); PG8_MMA(1, 0, At, B0); PG8_BAR; PG8_SCHED;
            PG8_STAGE(PG8_SB(0, 1), b2 + hstep, voffB);
            PG8_WAIT_V(6); PG8_BAR; PG8_MMA(1, 1, At, B1); PG8_BAR;
            PG8_LDB(B0, 1, 0); PG8_SCHED; PG8_LDA(At, 1, 0); PG8_STAGE(PG8_SA(0, 1), a2 + hstep, voffA);
            PG8_WAIT_L(8); PG8_BAR; PG8_WAIT_L(0); PG8_MMA(0, 0, At, B0); PG8_BAR; PG8_SCHED;
            PG8_LDB(B1, 1, 1); PG8_STAGE(PG8_SB(1, 0), b3, voffB);
            PG8_BAR; PG8_WAIT_L(0); PG8_MMA(0, 1, At, B1); PG8_BAR;
            PG8_LDA(At, 1, 1); PG8_STAGE(PG8_SA(1, 0), a3, voffA);
            PG8_BAR; PG8_WAIT_L(0); PG8_MMA(1, 0, At, B0); PG8_BAR; PG8_SCHED;
            PG8_STAGE(PG8_SB(1, 1), b3 + hstep, voffB);
            PG8_WAIT_V(6); PG8_BAR; PG8_MMA(1, 1, At, B1); PG8_BAR;
            }
        }
        if constexpr (ALIGN_EPI) { if (wr == 0) PG8_BAR; }
        if constexpr (!Epi::AFTER_DRAIN) { E(acc, cur, wr, wc, fr, fq); S.done(cur); }
        if (!has_next) break;
#pragma unroll
        for (int a = 0; a < 2; ++a)
#pragma unroll
            for (int b = 0; b < 2; ++b)
#pragma unroll
                for (int m = 0; m < 4; ++m)
#pragma unroll
                    for (int n = 0; n < 2; ++n) acc[a][b][m][n] = (f32x4){0.f, 0.f, 0.f, 0.f};
        cur = nxt; cA = nA; cB = nB; ++ui;
        if constexpr (ALIGN_EPI) { if (wr == 1) PG8_BAR; }
    }
    PG8_WAIT_V(0);
    if constexpr (!ALIGN_EPI) { if (wr == 0) PG8_BAR; }
    PG8_BAR;
    if constexpr (Epi::AFTER_DRAIN) { E.fused(acc, cur, wr, wc, fr, fq, lds, wid, lane); S.done(cur); }
#undef PG8_SA
#undef PG8_SB
#undef PG8_STAGE
#undef PG8_LDA
#undef PG8_LDB
#undef PG8_MMA
#undef PG8_WAIT_V
#undef PG8_WAIT_L
#undef PG8_BAR
#undef PG8_SCHED
}
}
namespace pg8 {
struct EpiResF32 {
    static constexpr bool PERM = false, AFTER_DRAIN = false;
    const float* xp; const float* xs; int split_pm; float* out; int ldc; float alpha;
    __device__ __forceinline__ void operator()(const f32x4 (&acc)[2][2][4][2], const Unit& u, int wr, int wc, int fr, int fq) const {
        const int col0 = u.pn * BM + wc * 32 + 4 * fq;
        const float* bp = (u.pm < split_pm) ? xp + (size_t)u.pm * BM * ldc : xs + (size_t)(u.pm - split_pm) * BM * ldc;
        float* op = out + (size_t)u.pm * BM * ldc;
#pragma unroll
        for (int ai = 0; ai < 2; ++ai)
#pragma unroll
            for (int m = 0; m < 4; ++m) { const size_t off = (size_t)(ai * HALF + wr * 64 + m * 16 + fr) * ldc + col0;
#pragma unroll
                for (int bj = 0; bj < 2; ++bj)
#pragma unroll
                    for (int n = 0; n < 2; ++n) { const f32x4 bs = *(const f32x4*)(bp + off + bj * HALF + n * 16); const f32x4 o = bs * alpha + acc[ai][bj][m][n]; *(f32x4*)(op + off + bj * HALF + n * 16) = o; }
                if (m & 1) asm volatile("" ::: "memory"); }
    }
};
struct EpiResBf16In {
    static constexpr bool PERM = false, AFTER_DRAIN = false;
    const bf16_t* h; float* out; int ldc; float alpha;
    __device__ __forceinline__ void operator()(const f32x4 (&acc)[2][2][4][2], const Unit& u, int wr, int wc, int fr, int fq) const {
        typedef unsigned u32x2v __attribute__((ext_vector_type(2)));
        const int col0 = u.pn * BM + wc * 32 + 4 * fq;
#pragma unroll
        for (int ai = 0; ai < 2; ++ai)
#pragma unroll
            for (int m = 0; m < 4; ++m) { const size_t off = (size_t)(u.pm * BM + ai * HALF + wr * 64 + m * 16 + fr) * ldc + col0;
#pragma unroll
                for (int bj = 0; bj < 2; ++bj)
#pragma unroll
                    for (int n = 0; n < 2; ++n) { const u32x2v hb = *(const u32x2v*)(h + off + bj * HALF + n * 16);
                        f32x4 bs; bs[0] = __uint_as_float(hb.x << 16); bs[1] = __uint_as_float(hb.x & 0xffff0000u); bs[2] = __uint_as_float(hb.y << 16); bs[3] = __uint_as_float(hb.y & 0xffff0000u);
                        const f32x4 o = bs * alpha + acc[ai][bj][m][n]; *(f32x4*)(out + off + bj * HALF + n * 16) = o; }
                if (m & 1) asm volatile("" ::: "memory"); }
    }
};
struct EpiSwiglu {
    static constexpr bool PERM = true, AFTER_DRAIN = false;
    bf16_t* O; int ldc;
    __device__ __forceinline__ void operator()(const f32x4 (&acc)[2][2][4][2], const Unit& u, int wr, int wc, int fr, int fq) const {
        const int row0 = u.pm * BM + wr * 64 + fr; const int col0 = u.pn * HALF + wc * 32 + 8 * fq;
#pragma unroll
        for (int ai = 0; ai < 2; ++ai)
#pragma unroll
            for (int m = 0; m < 4; ++m) { bf16_t* rowp = O + (size_t)(row0 + ai * HALF + m * 16) * ldc + col0;
                float v[8];
#pragma unroll
                for (int n = 0; n < 2; ++n)
#pragma unroll
                    for (int e = 0; e < 4; ++e) { const float g = acc[ai][0][m][n][e], up = acc[ai][1][m][n][e]; v[n * 4 + e] = g * __builtin_amdgcn_rcpf(1.0f + __expf(-g)) * up; }
                u32x4 w; w.x = cvt_pk_bf16(v[0], v[1]); w.y = cvt_pk_bf16(v[2], v[3]); w.z = cvt_pk_bf16(v[4], v[5]); w.w = cvt_pk_bf16(v[6], v[7]);
                *(u32x4*)rowp = w; }
    }
};
}
#define LAS __attribute__((address_space(3)))
typedef unsigned short bf16;
typedef short bf16x8 __attribute__((ext_vector_type(8)));
typedef short s16x4 __attribute__((ext_vector_type(4)));
typedef float f32x4 __attribute__((ext_vector_type(4)));
typedef float f32x16 __attribute__((ext_vector_type(16)));
typedef unsigned u32x4 __attribute__((ext_vector_type(4)));
typedef unsigned u32x2 __attribute__((ext_vector_type(2)));

constexpr int NWAVES = 8, NTHREADS = 512;
constexpr int DM = 1024, BATCH = 8, SEQ = 4096, DEC_T = 64;
constexpr int MP = BATCH * SEQ, MS = BATCH * DEC_T, M = MP + MS;
constexpr int NCH_P = MP / 64, NCH = M / 64;
constexpr int IN_COLS = 2312, NPROJ = 2304, DFF = 2816, NGU = 2 * DFF;
constexpr int PC_Z = 0, PC_XS = 512, PC_B = 1024, PC_C = 1280, PC_Q = 1536, PC_K = 2048, PC_V = 2176;
constexpr float LN_EPS = 1e-5f, RMS_EPS = 1e-5f, ALPHA = 1.189207115002721f;
constexpr size_t MiB = 1u << 20;
constexpr size_t WS_WIN = 2 * MiB, WS_WOUT = 7 * MiB, WS_WGU = 9 * MiB, WS_WDN = 20 * MiB, WS_DT = 26 * MiB, WS_CDEC = 28 * MiB;
constexpr size_t WS_XB = 32 * MiB, WS_MIXED = WS_XB, WS_PROJ = 97 * MiB, WS_BSTATE = 244 * MiB, WS_SPREV = 374 * MiB, WS_H = 97 * MiB, WS_ACT = 162 * MiB, WS_END = 439 * MiB;
static_assert(WS_XB + (size_t)M * DM * 2 <= WS_PROJ && WS_PROJ + (size_t)M * NPROJ * 2 <= WS_BSTATE && WS_BSTATE + (size_t)NCH * 65536 * 4 <= WS_SPREV && WS_SPREV + (size_t)NCH * 65536 * 2 <= WS_END, "ws map");
static_assert(WS_H + (size_t)M * DM * 2 <= WS_ACT && WS_ACT + (size_t)M * DFF * 2 <= WS_END, "ws map 2");
constexpr size_t O_Y = 0, O_CONVP = (size_t)M * DM, O_SSMP = O_CONVP + 24576, O_KP = O_SSMP + 524288, O_VP = O_KP + 131072, O_CONVS = O_VP + 131072, O_SSMS = O_CONVS + 24576, O_KS = O_SSMS + 524288, O_VS = O_KS + 131072, O_END = O_VS + 131072;
constexpr int LDS_BYTES = 147456;

struct Params {
    const float *x_prompt, *x_sample, *state_conv, *state_ssm, *cache_k, *cache_v, *w_in, *conv_w, *conv_b, *dt_bias, *a_log, *d_skip, *ssm_norm_w, *attn_sinks,
                *w_out, *ln1_g, *ln1_b, *w_gate, *w_up, *w_down, *ln2_g, *ln2_b;
    float* out; unsigned char* ws;
};

__device__ __forceinline__ float bf2f(unsigned short h) { return __uint_as_float((unsigned)h << 16); }
__device__ __forceinline__ unsigned pk2(float lo, float hi) { return pg8::cvt_pk_bf16(lo, hi); }
__device__ __forceinline__ float wave_sum(float v) {
#pragma unroll
    for (int o = 1; o < 64; o <<= 1) v += __shfl_xor(v, o);
    return v;
}
__device__ __forceinline__ float silu_f(float v) { return v * __builtin_amdgcn_rcpf(1.0f + __expf(-v)); }
__device__ __forceinline__ void unpack8(const u32x4 w, float (&f)[8]) {
    f[0] = __uint_as_float(w.x << 16); f[1] = __uint_as_float(w.x & 0xffff0000u); f[2] = __uint_as_float(w.y << 16); f[3] = __uint_as_float(w.y & 0xffff0000u);
    f[4] = __uint_as_float(w.z << 16); f[5] = __uint_as_float(w.z & 0xffff0000u); f[6] = __uint_as_float(w.w << 16); f[7] = __uint_as_float(w.w & 0xffff0000u);
}

__device__ __forceinline__ void p0_item(const float* W, int ldw, int k0, int nsrc0, bf16* WT, int K, int drow0, LAS float* scr, int lane) {
#pragma unroll 8
    for (int i = 0; i < 32; ++i) { const int kk = 2 * i + (lane >> 5); scr[kk * 33 + (lane & 31)] = W[(size_t)(k0 + kk) * ldw + nsrc0 + (lane & 31)]; }
    asm volatile("s_waitcnt lgkmcnt(0)" ::: "memory");
    const int c = lane & 7;
#pragma unroll
    for (int j = 0; j < 4; ++j) { const int n = (lane >> 3) + 8 * j; const LAS float* s = scr + (8 * c) * 33 + n;
        u32x4 o; o.x = pk2(s[0 * 33], s[1 * 33]); o.y = pk2(s[2 * 33], s[3 * 33]); o.z = pk2(s[4 * 33], s[5 * 33]); o.w = pk2(s[6 * 33], s[7 * 33]);
        *(u32x4*)(WT + (size_t)(drow0 + n) * K + k0 + 8 * c) = o; }
    asm volatile("s_waitcnt lgkmcnt(0)" ::: "memory");
}

__device__ __forceinline__ void p0_prologue(const Params& P, LAS unsigned char* lds, int tid, int lane, int wave, int G) {
    unsigned char* ws = P.ws;
    bf16* WIN = (bf16*)(ws + WS_WIN); bf16* WOUT = (bf16*)(ws + WS_WOUT); bf16* WGU = (bf16*)(ws + WS_WGU); bf16* WDN = (bf16*)(ws + WS_WDN);
    bf16* XB = (bf16*)(ws + WS_XB); float* DT = (float*)(ws + WS_DT);
    LAS float* scr = (LAS float*)(lds + wave * 8448);
    LAS float* wdt = (LAS float*)(lds + 73728);
    for (int i = tid; i < 8192; i += NTHREADS) { const int k = i >> 3, h = i & 7; wdt[h * 1024 + k] = P.w_in[(size_t)k * IN_COLS + 1536 + h]; }
    const int gw = blockIdx.x * NWAVES + wave, NGW = G * NWAVES;
    constexpr int I_IN = 16 * 72, I_OUT = 16 * 32, I_GU = 16 * 176, I_DN = 44 * 32, NITEMS = I_IN + I_OUT + I_GU + I_DN;
    for (int it = gw; it < NITEMS; it += NGW) {
        int r = it;
        if (r < I_IN) { const int kb = r / 72, nb = r % 72, n0 = 32 * nb; p0_item(P.w_in, IN_COLS, 64 * kb, n0 + (n0 >= 1536 ? 8 : 0), WIN, DM, n0, scr, lane); continue; } r -= I_IN;
        if (r < I_OUT) { const int kb = r / 32, nb = r % 32; p0_item(P.w_out, DM, 64 * kb, 32 * nb, WOUT, DM, 32 * nb, scr, lane); continue; } r -= I_OUT;
        if (r < I_GU) { const int kb = r / 176, nb = r % 176, t = nb >> 3, s = (nb >> 2) & 1, i0 = 32 * (nb & 3); p0_item(s ? P.w_up : P.w_gate, DFF, 64 * kb, 128 * t + i0, WGU, DM, 32 * nb, scr, lane); continue; } r -= I_GU;
        { const int kb = r / 32, nb = r % 32; p0_item(P.w_down, DM, 64 * kb, 32 * nb, WDN, DFF, 32 * nb, scr, lane); }
    }
    __syncthreads();
    float bias = 0.f; if (lane < 8) bias = P.dt_bias[lane];
    for (int m = gw; m < M; m += NGW) {
        const float* xrow = (m < MP) ? P.x_prompt + (size_t)m * DM : P.x_sample + (size_t)(m - MP) * DM;
        f32x4 v[4];
#pragma unroll
        for (int j = 0; j < 4; ++j) v[j] = *(const f32x4*)(xrow + 4 * lane + 256 * j);
        unsigned long long* o8 = (unsigned long long*)(XB + (size_t)m * DM) + lane;
#pragma unroll
        for (int j = 0; j < 4; ++j) o8[64 * j] = (unsigned long long)pk2(v[j][0], v[j][1]) | ((unsigned long long)pk2(v[j][2], v[j][3]) << 32);
        float mine = 0.f;
#pragma unroll
        for (int h = 0; h < 8; ++h) { float a = 0.f;
#pragma unroll
            for (int j = 0; j < 4; ++j) { const f32x4 w = *(const LAS f32x4*)(wdt + h * 1024 + 4 * lane + 256 * j); a += v[j][0] * w[0] + v[j][1] * w[1] + v[j][2] * w[2] + v[j][3] * w[3]; }
            a = wave_sum(a); if (lane == h) mine = a; }
        if (lane < 8) { const float xx = mine + bias; DT[(size_t)m * 8 + lane] = (xx > 20.f) ? xx : log1pf(__expf(xx)); }
    }
}

__device__ __forceinline__ void conv8x4(const Params& P, const bf16* PROJ, int cid, int pcol, int cch, int t0, float (&o)[4][8]) {
    const bool sample = cid >= NCH_P; const bool has_prev = (!sample) && ((cid & 63) != 0);
    const size_t m0 = (size_t)cid * 64;
    float xin[7][8];
#pragma unroll
    for (int rr = 0; rr < 7; ++rr) { const int lt = t0 - 3 + rr;
        if (lt >= 0 || has_prev) { const u32x4 w = *(const u32x4*)(PROJ + (size_t)((long)m0 + lt) * NPROJ + pcol); unpack8(w, xin[rr]); }
        else if (sample) { const float* sc = P.state_conv + ((size_t)(cid - NCH_P) * 3 + (lt + 3)) * 1024 + cch; const f32x4 a = *(const f32x4*)sc, b = *(const f32x4*)(sc + 4);
            xin[rr][0] = a[0]; xin[rr][1] = a[1]; xin[rr][2] = a[2]; xin[rr][3] = a[3]; xin[rr][4] = b[0]; xin[rr][5] = b[1]; xin[rr][6] = b[2]; xin[rr][7] = b[3]; }
        else {
#pragma unroll
            for (int e = 0; e < 8; ++e) xin[rr][e] = 0.f; } }
    float cw[4][8], cb[8];
#pragma unroll
    for (int i = 0; i < 4; ++i) { const f32x4 a = *(const f32x4*)(P.conv_w + i * 1024 + cch), b = *(const f32x4*)(P.conv_w + i * 1024 + cch + 4);
        cw[i][0] = a[0]; cw[i][1] = a[1]; cw[i][2] = a[2]; cw[i][3] = a[3]; cw[i][4] = b[0]; cw[i][5] = b[1]; cw[i][6] = b[2]; cw[i][7] = b[3]; }
    { const f32x4 a = *(const f32x4*)(P.conv_b + cch), b = *(const f32x4*)(P.conv_b + cch + 4); cb[0] = a[0]; cb[1] = a[1]; cb[2] = a[2]; cb[3] = a[3]; cb[4] = b[0]; cb[5] = b[1]; cb[6] = b[2]; cb[7] = b[3]; }
#pragma unroll
    for (int tt = 0; tt < 4; ++tt)
#pragma unroll
        for (int e = 0; e < 8; ++e) { float a = cb[e];
#pragma unroll
            for (int i = 0; i < 4; ++i) a += cw[i][e] * xin[tt + i][e];
            o[tt][e] = silu_f(a); }
}

constexpr int KS_STR = 72, VT_STR = 200;
__device__ __forceinline__ void attn_unit(const Params& P, LAS unsigned char* lds, int cid, int kv, int tid, int lane, int wave) {
    asm volatile("" : "+v"(tid), "+v"(lane));
    const bf16* PROJ = (const bf16*)(P.ws + WS_PROJ); bf16* MIXED = (bf16*)(P.ws + WS_MIXED);
    LAS bf16* Ks = (LAS bf16*)lds; LAS bf16* VT = (LAS bf16*)(lds + 192 * KS_STR * 2);
    const bool sample = cid >= NCH_P; const int c = cid & 63; const size_t m0 = (size_t)cid * 64;
    for (int idx = tid; idx < 1536; idx += NTHREADS) { const int j = idx >> 3, ch = idx & 7;
        u32x4 k8 = (u32x4){0u, 0u, 0u, 0u}, v8 = (u32x4){0u, 0u, 0u, 0u};
        if (sample && j < 128) { const size_t o = (((size_t)(cid - NCH_P) * 128 + j) * 2 + kv) * 64 + ch * 8;
            const f32x4 a = *(const f32x4*)(P.cache_k + o), b = *(const f32x4*)(P.cache_k + o + 4), cc = *(const f32x4*)(P.cache_v + o), d = *(const f32x4*)(P.cache_v + o + 4);
            k8.x = pk2(a[0], a[1]); k8.y = pk2(a[2], a[3]); k8.z = pk2(b[0], b[1]); k8.w = pk2(b[2], b[3]);
            v8.x = pk2(cc[0], cc[1]); v8.y = pk2(cc[2], cc[3]); v8.z = pk2(d[0], d[1]); v8.w = pk2(d[2], d[3]); }
        else if (sample || (c * 64 - 128 + j >= 0)) { const bf16* rp = PROJ + (size_t)((long)m0 - 128 + j) * NPROJ + kv * 64 + ch * 8; k8 = *(const u32x4*)(rp + PC_K); v8 = *(const u32x4*)(rp + PC_V); }
        *(LAS u32x4*)(Ks + j * KS_STR + ch * 8) = k8;
        LAS bf16* vp = VT + (ch * 8) * VT_STR + j;
        vp[0 * VT_STR] = (bf16)(v8.x & 0xffff); vp[1 * VT_STR] = (bf16)(v8.x >> 16); vp[2 * VT_STR] = (bf16)(v8.y & 0xffff); vp[3 * VT_STR] = (bf16)(v8.y >> 16);
        vp[4 * VT_STR] = (bf16)(v8.z & 0xffff); vp[5 * VT_STR] = (bf16)(v8.z >> 16); vp[6 * VT_STR] = (bf16)(v8.w & 0xffff); vp[7 * VT_STR] = (bf16)(v8.w >> 16); }
    __syncthreads();
    const int r = wave >> 1, th = wave & 1, hq = kv * 4 + r, l31 = lane & 31, hh = lane >> 5; int tq = 32 * th + l31; asm volatile("" : "+v"(tq));
    const bf16* qp = PROJ + (m0 + tq) * NPROJ + PC_Q + hq * 64 + 8 * hh;
    bf16x8 qf[4];
#pragma unroll
    for (int ks = 0; ks < 4; ++ks) qf[ks] = *(const bf16x8*)(qp + 16 * ks);
    f32x16 sacc[6];
#pragma unroll
    for (int kt = 0; kt < 6; ++kt) {
#pragma unroll
        for (int i = 0; i < 16; ++i) sacc[kt][i] = 0.f;
#pragma unroll
        for (int ks = 0; ks < 4; ++ks) { const bf16x8 a = *(const LAS bf16x8*)(Ks + (32 * kt + l31) * KS_STR + 16 * ks + 8 * hh); sacc[kt] = __builtin_amdgcn_mfma_f32_32x32x16_bf16(a, qf[ks], sacc[kt], 0, 0, 0); }
        __builtin_amdgcn_sched_barrier(0); }
    const float slope = exp2f(-(float)(hq + 1)), sink = P.attn_sinks[hq];
    float mx = sink;
#pragma unroll
    for (int kt = 0; kt < 6; ++kt) { const bool valid = sample || (2 * c + kt >= 4);
#pragma unroll
        for (int i = 0; i < 16; ++i) { const int key = 32 * kt + (i & 3) + 8 * (i >> 2) + 4 * hh; const float dist = fabsf((float)(128 + tq - key));
            const float s = valid ? (sacc[kt][i] * 0.125f - slope * dist) : -INFINITY; sacc[kt][i] = s; mx = fmaxf(mx, s); }
        __builtin_amdgcn_sched_barrier(0); }
    mx = fmaxf(mx, __shfl_xor(mx, 32));
    float sum = 0.f;
#pragma unroll
    for (int kt = 0; kt < 6; ++kt)
#pragma unroll
        for (int i = 0; i < 16; ++i) { const float p = __expf(sacc[kt][i] - mx); sacc[kt][i] = p; sum += p; }
    sum += __shfl_xor(sum, 32);
    const float inv = 1.0f / (sum + __expf(sink - mx));
    f32x16 oacc[2];
#pragma unroll
    for (int d2 = 0; d2 < 2; ++d2)
#pragma unroll
        for (int i = 0; i < 16; ++i) oacc[d2][i] = 0.f;
#pragma unroll
    for (int kt = 0; kt < 6; ++kt)
#pragma unroll
        for (int s2 = 0; s2 < 2; ++s2) {
            union { u32x4 u; bf16x8 v; } pf;
            pf.u.x = pk2(sacc[kt][8 * s2 + 0], sacc[kt][8 * s2 + 1]); pf.u.y = pk2(sacc[kt][8 * s2 + 2], sacc[kt][8 * s2 + 3]);
            pf.u.z = pk2(sacc[kt][8 * s2 + 4], sacc[kt][8 * s2 + 5]); pf.u.w = pk2(sacc[kt][8 * s2 + 6], sacc[kt][8 * s2 + 7]);
#pragma unroll
            for (int d2 = 0; d2 < 2; ++d2) { const LAS bf16* vp = VT + (32 * d2 + l31) * VT_STR + 32 * kt + 16 * s2 + 4 * hh;
                union { u32x4 u; bf16x8 v; } af; const u32x2 lo = *(const LAS u32x2*)vp, hi = *(const LAS u32x2*)(vp + 8); af.u.x = lo.x; af.u.y = lo.y; af.u.z = hi.x; af.u.w = hi.y;
                oacc[d2] = __builtin_amdgcn_mfma_f32_32x32x16_bf16(af.v, pf.v, oacc[d2], 0, 0, 0); }
            __builtin_amdgcn_sched_barrier(0); }
    bf16* op = MIXED + (m0 + tq) * DM + 512 + hq * 64 + 4 * hh;
#pragma unroll
    for (int d2 = 0; d2 < 2; ++d2)
#pragma unroll
        for (int rg = 0; rg < 4; ++rg) { u32x2 w; w.x = pk2(oacc[d2][4 * rg] * inv, oacc[d2][4 * rg + 1] * inv); w.y = pk2(oacc[d2][4 * rg + 2] * inv, oacc[d2][4 * rg + 3] * inv);
            *(u32x2*)(op + 32 * d2 + 8 * rg) = w; }
    __syncthreads();
}

constexpr int XT_STR = 72, BM_STR = 136, CB_STR = 68;
__device__ __forceinline__ float wave_incl_scan(float v, int lane) {
#pragma unroll
    for (int o = 1; o < 64; o <<= 1) { const float t = __shfl_up(v, o); if (lane >= o) v += t; }
    return v;
}
__device__ __forceinline__ void bstate_unit(const Params& P, LAS unsigned char* lds, int cid, int g, int tid, int lane, int wave) {
    asm volatile("" : "+v"(tid), "+v"(lane));
    const bf16* PROJ = (const bf16*)(P.ws + WS_PROJ); const float* DT = (const float*)(P.ws + WS_DT); float* CDEC = (float*)(P.ws + WS_CDEC); float* BST = (float*)(P.ws + WS_BSTATE);
    LAS bf16* xsT = (LAS bf16*)lds;
    LAS bf16* BmT = (LAS bf16*)(lds + 256 * XT_STR * 2);
    LAS float* wsc = (LAS float*)(lds + 256 * XT_STR * 2 + 128 * XT_STR * 2);
    const size_t m0 = (size_t)cid * 64;
    if (wave < 4) { const int h = 4 * g + wave; const float dt = DT[(m0 + lane) * 8 + h]; const float a = -__expf(P.a_log[h]);
        const float cum = wave_incl_scan(dt * a, lane); const float tot = __shfl(cum, 63);
        wsc[wave * 64 + lane] = dt * __expf(tot - cum); if (lane == 63) CDEC[cid * 8 + h] = __expf(tot); }
    __syncthreads();
    { const int cg8 = tid & 31, seg = tid >> 5, t0 = 4 * seg; float o[4][8];
        conv8x4(P, PROJ, cid, PC_XS + 256 * g + 8 * cg8, 256 * g + 8 * cg8, t0, o);
        const int hh = cg8 >> 3; const f32x4 w4 = *(const LAS f32x4*)(wsc + hh * 64 + t0);
#pragma unroll
        for (int e = 0; e < 8; ++e) { u32x2 w; w.x = pk2(o[0][e] * w4[0], o[1][e] * w4[1]); w.y = pk2(o[2][e] * w4[2], o[3][e] * w4[3]); *(LAS u32x2*)(xsT + (8 * cg8 + e) * XT_STR + t0) = w; } }
    if (tid < 256) { const int cg8 = tid & 15, seg = tid >> 4, t0 = 4 * seg; float o[4][8];
        conv8x4(P, PROJ, cid, PC_B + 128 * g + 8 * cg8, 512 + 128 * g + 8 * cg8, t0, o);
#pragma unroll
        for (int e = 0; e < 8; ++e) { u32x2 w; w.x = pk2(o[0][e], o[1][e]); w.y = pk2(o[2][e], o[3][e]); *(LAS u32x2*)(BmT + (8 * cg8 + e) * XT_STR + t0) = w; } }
    __syncthreads();
    const int hh = wave >> 1, ph = wave & 1, h = 4 * g + hh, fr = lane & 15, fq = lane >> 4;
    f32x4 acc[2][8];
#pragma unroll
    for (int pt = 0; pt < 2; ++pt)
#pragma unroll
        for (int nt = 0; nt < 8; ++nt) acc[pt][nt] = (f32x4){0.f, 0.f, 0.f, 0.f};
#pragma unroll
    for (int ks = 0; ks < 2; ++ks) { bf16x8 a[2];
#pragma unroll
        for (int pt = 0; pt < 2; ++pt) a[pt] = *(const LAS bf16x8*)(xsT + (64 * hh + 32 * ph + 16 * pt + fr) * XT_STR + 32 * ks + 8 * fq);
#pragma unroll
        for (int nt = 0; nt < 8; ++nt) { const bf16x8 b = *(const LAS bf16x8*)(BmT + (16 * nt + fr) * XT_STR + 32 * ks + 8 * fq);
#pragma unroll
            for (int pt = 0; pt < 2; ++pt) acc[pt][nt] = __builtin_amdgcn_mfma_f32_16x16x32_bf16(a[pt], b, acc[pt][nt], 0, 0, 0); } }
    float* bp = BST + ((size_t)cid * 8 + h) * 8192;
#pragma unroll
    for (int pt = 0; pt < 2; ++pt)
#pragma unroll
        for (int nt = 0; nt < 8; ++nt)
#pragma unroll
            for (int i = 0; i < 4; ++i) bp[(32 * ph + 16 * pt + 4 * fq + i) * 128 + 16 * nt + fr] = acc[pt][nt][i];
    __syncthreads();
}

__device__ __forceinline__ void p3_scan(const Params& P, int tid, int G) {
    asm volatile("" : "+v"(tid));
    const float* CDEC = (const float*)(P.ws + WS_CDEC); const float* BST = (const float*)(P.ws + WS_BSTATE); bf16* SPV = (bf16*)(P.ws + WS_SPREV); const bf16* PROJ = (const bf16*)(P.ws + WS_PROJ);
    const int gt = blockIdx.x * NTHREADS + tid, NT = G * NTHREADS;
    for (int item = gt; item < 131072; item += NT) { const int b = item >> 14, e = item & 16383, h = e >> 11; const size_t eo = (size_t)e * 4;
        f32x4 s = (f32x4){0.f, 0.f, 0.f, 0.f};
        for (int c0 = 0; c0 < 64; c0 += 8) { f32x4 bs[8]; float dc[8];
#pragma unroll
            for (int u = 0; u < 8; ++u) { const size_t cid = (size_t)b * 64 + c0 + u; bs[u] = *(const f32x4*)(BST + cid * 65536 + eo); dc[u] = CDEC[cid * 8 + h]; }
#pragma unroll
            for (int u = 0; u < 8; ++u) { const size_t cid = (size_t)b * 64 + c0 + u; u32x2 w; w.x = pk2(s[0], s[1]); w.y = pk2(s[2], s[3]); *(u32x2*)(SPV + cid * 65536 + eo) = w; s = s * dc[u] + bs[u]; } }
        *(f32x4*)(P.out + O_SSMP + (size_t)b * 65536 + eo) = s;
        { const size_t cid = NCH_P + b; const f32x4 s0 = *(const f32x4*)(P.state_ssm + (size_t)b * 65536 + eo); u32x2 w; w.x = pk2(s0[0], s0[1]); w.y = pk2(s0[2], s0[3]); *(u32x2*)(SPV + cid * 65536 + eo) = w;
            *(f32x4*)(P.out + O_SSMS + (size_t)b * 65536 + eo) = s0 * CDEC[cid * 8 + h] + *(const f32x4*)(BST + cid * 65536 + eo); } }
    for (int i = gt; i < 24576; i += NT) { const int b = i / 3072, r = (i / 1024) % 3, ch = i & 1023;
        P.out[O_CONVP + i] = bf2f(PROJ[((size_t)b * SEQ + SEQ - 3 + r) * NPROJ + PC_XS + ch]);
        P.out[O_CONVS + i] = bf2f(PROJ[((size_t)MP + b * 64 + 61 + r) * NPROJ + PC_XS + ch]); }
    for (int i = gt; i < 131072; i += NT) { const int b = i >> 14, j = (i >> 7) & 127, kd = i & 127;
        const size_t rp = ((size_t)b * SEQ + SEQ - 128 + j) * NPROJ;
        P.out[O_KP + i] = bf2f(PROJ[rp + PC_K + kd]); P.out[O_VP + i] = bf2f(PROJ[rp + PC_V + kd]);
        if (j < 64) { const size_t o = ((size_t)b * 128 + j + 64) * 128 + kd; P.out[O_KS + i] = P.cache_k[o]; P.out[O_VS + i] = P.cache_v[o]; }
        else { const size_t rs = ((size_t)MP + b * 64 + j - 64) * NPROJ; P.out[O_KS + i] = bf2f(PROJ[rs + PC_K + kd]); P.out[O_VS + i] = bf2f(PROJ[rs + PC_V + kd]); } }
}

constexpr int YT_STR = 260;
__device__ __forceinline__ void ssd_unit(const Params& P, LAS unsigned char* lds, int cid, int g, int tid, int lane, int wave) {
    asm volatile("" : "+v"(tid), "+v"(lane));
    const bf16* PROJ = (const bf16*)(P.ws + WS_PROJ); const float* DT = (const float*)(P.ws + WS_DT); const bf16* SPV = (const bf16*)(P.ws + WS_SPREV); bf16* MIXED = (bf16*)(P.ws + WS_MIXED);
    LAS bf16* xsT = (LAS bf16*)lds;
    LAS bf16* Bm = (LAS bf16*)(lds + 36864);
    LAS bf16* Cm = (LAS bf16*)(lds + 36864 + 17408);
    LAS float* CB = (LAS float*)(lds + 36864 + 2 * 17408);
    LAS float* dts = (LAS float*)(lds + 36864 + 3 * 17408);
    LAS float* cums = dts + 256;
    LAS float* yt = (LAS float*)lds;
    const size_t m0 = (size_t)cid * 64;
    if (wave < 4) { const int h = 4 * g + wave; const float dt = DT[(m0 + lane) * 8 + h]; const float a = -__expf(P.a_log[h]);
        const float cum = wave_incl_scan(dt * a, lane); dts[wave * 64 + lane] = dt; cums[wave * 64 + lane] = cum; }
    { const int cg8 = tid & 31, seg = tid >> 5, t0 = 4 * seg; float o[4][8];
        conv8x4(P, PROJ, cid, PC_XS + 256 * g + 8 * cg8, 256 * g + 8 * cg8, t0, o);
#pragma unroll
        for (int e = 0; e < 8; ++e) { u32x2 w; w.x = pk2(o[0][e], o[1][e]); w.y = pk2(o[2][e], o[3][e]); *(LAS u32x2*)(xsT + (8 * cg8 + e) * XT_STR + t0) = w; }
        const int isC = cg8 >> 4, c16 = cg8 & 15;
        conv8x4(P, PROJ, cid, (isC ? PC_C : PC_B) + 128 * g + 8 * c16, (isC ? 768 : 512) + 128 * g + 8 * c16, t0, o);
        LAS bf16* dst = isC ? Cm : Bm;
#pragma unroll
        for (int tt = 0; tt < 4; ++tt) { u32x4 w; w.x = pk2(o[tt][0], o[tt][1]); w.y = pk2(o[tt][2], o[tt][3]); w.z = pk2(o[tt][4], o[tt][5]); w.w = pk2(o[tt][6], o[tt][7]); *(LAS u32x4*)(dst + (t0 + tt) * BM_STR + 8 * c16) = w; } }
    __syncthreads();
    const int fr = lane & 15, fq = lane >> 4;
    { const int lt = wave >> 1, st0 = 2 * (wave & 1); f32x4 ca[2] = {(f32x4){0.f, 0.f, 0.f, 0.f}, (f32x4){0.f, 0.f, 0.f, 0.f}};
#pragma unroll
        for (int ks = 0; ks < 4; ++ks) { const bf16x8 a = *(const LAS bf16x8*)(Cm + (16 * lt + fr) * BM_STR + 32 * ks + 8 * fq);
#pragma unroll
            for (int u = 0; u < 2; ++u) { const bf16x8 b = *(const LAS bf16x8*)(Bm + (16 * (st0 + u) + fr) * BM_STR + 32 * ks + 8 * fq); ca[u] = __builtin_amdgcn_mfma_f32_16x16x32_bf16(a, b, ca[u], 0, 0, 0); } }
#pragma unroll
        for (int u = 0; u < 2; ++u)
#pragma unroll
            for (int i = 0; i < 4; ++i) CB[(16 * lt + 4 * fq + i) * CB_STR + 16 * (st0 + u) + fr] = ca[u][i]; }
    __syncthreads();
    const int hh = wave >> 1, ph = wave & 1, h = 4 * g + hh;
    f32x4 acc[4][2];
#pragma unroll
    for (int lt = 0; lt < 4; ++lt)
#pragma unroll
        for (int pt = 0; pt < 2; ++pt) acc[lt][pt] = (f32x4){0.f, 0.f, 0.f, 0.f};
    {
        bf16x8 sb[2][4]; const bf16* sp = SPV + (((size_t)cid * 8 + h) * 64 + 32 * ph + fr) * 128 + 8 * fq;
#pragma unroll
        for (int pt = 0; pt < 2; ++pt)
#pragma unroll
            for (int ks = 0; ks < 4; ++ks) sb[pt][ks] = *(const bf16x8*)(sp + (size_t)pt * 16 * 128 + 32 * ks);
#pragma unroll
        for (int lt = 0; lt < 4; ++lt)
#pragma unroll
            for (int ks = 0; ks < 4; ++ks) { const bf16x8 a = *(const LAS bf16x8*)(Cm + (16 * lt + fr) * BM_STR + 32 * ks + 8 * fq);
#pragma unroll
                for (int pt = 0; pt < 2; ++pt) acc[lt][pt] = __builtin_amdgcn_mfma_f32_16x16x32_bf16(a, sb[pt][ks], acc[lt][pt], 0, 0, 0); }
#pragma unroll
        for (int lt = 0; lt < 4; ++lt) { const f32x4 c4 = *(const LAS f32x4*)(cums + hh * 64 + 16 * lt + 4 * fq);
#pragma unroll
            for (int i = 0; i < 4; ++i) { const float e = __expf(c4[i]); acc[lt][0][i] *= e; acc[lt][1][i] *= e; } }
    }
#pragma unroll
    for (int lt = 0; lt < 4; ++lt)
#pragma unroll
        for (int ks = 0; ks < 2; ++ks) { if (32 * ks > 16 * lt + 15) continue;
            const int l = 16 * lt + fr, s0 = 32 * ks + 8 * fq; const float cl = cums[hh * 64 + l];
            const f32x4 cb0 = *(const LAS f32x4*)(CB + l * CB_STR + s0), cb1 = *(const LAS f32x4*)(CB + l * CB_STR + s0 + 4);
            const f32x4 cs0 = *(const LAS f32x4*)(cums + hh * 64 + s0), cs1 = *(const LAS f32x4*)(cums + hh * 64 + s0 + 4);
            const f32x4 d0 = *(const LAS f32x4*)(dts + hh * 64 + s0), d1 = *(const LAS f32x4*)(dts + hh * 64 + s0 + 4);
            float mv[8];
#pragma unroll
            for (int j = 0; j < 4; ++j) { mv[j] = (s0 + j <= l) ? cb0[j] * __expf(fminf(cl - cs0[j], 0.f)) * d0[j] : 0.f; mv[4 + j] = (s0 + 4 + j <= l) ? cb1[j] * __expf(fminf(cl - cs1[j], 0.f)) * d1[j] : 0.f; }
            union { u32x4 u; bf16x8 v; } af; af.u.x = pk2(mv[0], mv[1]); af.u.y = pk2(mv[2], mv[3]); af.u.z = pk2(mv[4], mv[5]); af.u.w = pk2(mv[6], mv[7]);
#pragma unroll
            for (int pt = 0; pt < 2; ++pt) { const bf16x8 b = *(const LAS bf16x8*)(xsT + (64 * hh + 32 * ph + 16 * pt + fr) * XT_STR + s0); acc[lt][pt] = __builtin_amdgcn_mfma_f32_16x16x32_bf16(af.v, b, acc[lt][pt], 0, 0, 0); } }
    { const float dsk = P.d_skip[h];
#pragma unroll
        for (int lt = 0; lt < 4; ++lt)
#pragma unroll
            for (int pt = 0; pt < 2; ++pt) { const u32x2 xw = *(const LAS u32x2*)(xsT + (64 * hh + 32 * ph + 16 * pt + fr) * XT_STR + 16 * lt + 4 * fq);
                acc[lt][pt][0] += dsk * __uint_as_float(xw.x << 16); acc[lt][pt][1] += dsk * __uint_as_float(xw.x & 0xffff0000u); acc[lt][pt][2] += dsk * __uint_as_float(xw.y << 16); acc[lt][pt][3] += dsk * __uint_as_float(xw.y & 0xffff0000u); } }
    __syncthreads();
#pragma unroll
    for (int lt = 0; lt < 4; ++lt)
#pragma unroll
        for (int pt = 0; pt < 2; ++pt)
#pragma unroll
            for (int i = 0; i < 4; ++i) yt[(16 * lt + 4 * fq + i) * YT_STR + 64 * hh + 32 * ph + 16 * pt + fr] = acc[lt][pt][i];
    __syncthreads();
    const f32x4 nw = *(const f32x4*)(P.ssm_norm_w + 256 * g + 4 * lane);
#pragma unroll
    for (int q = 0; q < 8; ++q) { const int l = 8 * wave + q; const f32x4 y = *(const LAS f32x4*)(yt + l * YT_STR + 4 * lane);
        const u32x2 zw = *(const u32x2*)(PROJ + (m0 + l) * NPROJ + PC_Z + 256 * g + 4 * lane);
        f32x4 gg; gg[0] = y[0] * silu_f(__uint_as_float(zw.x << 16)); gg[1] = y[1] * silu_f(__uint_as_float(zw.x & 0xffff0000u)); gg[2] = y[2] * silu_f(__uint_as_float(zw.y << 16)); gg[3] = y[3] * silu_f(__uint_as_float(zw.y & 0xffff0000u));
        const float ss = wave_sum(gg[0] * gg[0] + gg[1] * gg[1] + gg[2] * gg[2] + gg[3] * gg[3]); const float rs = 1.0f / sqrtf(ss * (1.0f / 256.0f) + RMS_EPS);
        u32x2 w; w.x = pk2(gg[0] * rs * nw[0], gg[1] * rs * nw[1]); w.y = pk2(gg[2] * rs * nw[2], gg[3] * rs * nw[3]);
        *(u32x2*)(MIXED + (m0 + l) * DM + 256 * g + 4 * lane) = w; }
    __syncthreads();
}

__device__ __forceinline__ void ln_rows(const float* in, const float* gam, const float* bet, bf16* obf, float* of32, int lane, int wave, int G) {
    asm volatile("" : "+v"(lane));
    const int gw = blockIdx.x * NWAVES + wave, NGW = G * NWAVES;
    f32x4 gv[4], bv[4];
#pragma unroll
    for (int j = 0; j < 4; ++j) { gv[j] = *(const f32x4*)(gam + 4 * lane + 256 * j); bv[j] = *(const f32x4*)(bet + 4 * lane + 256 * j); }
    for (int m = gw; m < M; m += NGW) { const float* xr = in + (size_t)m * DM + 4 * lane;
        f32x4 v[4]; float s = 0.f;
#pragma unroll
        for (int j = 0; j < 4; ++j) { v[j] = *(const f32x4*)(xr + 256 * j); s += (v[j][0] + v[j][1]) + (v[j][2] + v[j][3]); }
        const float mean = wave_sum(s) * (1.f / DM); float s2 = 0.f;
#pragma unroll
        for (int j = 0; j < 4; ++j) { v[j] = v[j] - mean; s2 += (v[j][0] * v[j][0] + v[j][1] * v[j][1]) + (v[j][2] * v[j][2] + v[j][3] * v[j][3]); }
        const float rstd = 1.f / sqrtf(wave_sum(s2) * (1.f / DM) + LN_EPS);
#pragma unroll
        for (int j = 0; j < 4; ++j) { const f32x4 o = v[j] * rstd * gv[j] + bv[j];
            if (obf) { u32x2 w; w.x = pk2(o[0], o[1]); w.y = pk2(o[2], o[3]); *(u32x2*)(obf + (size_t)m * DM + 4 * lane + 256 * j) = w; }
            if (of32) *(f32x4*)(of32 + (size_t)m * DM + 4 * lane + 256 * j) = o; } }
}

#ifndef PHMASK
#define PHMASK 0x3ff
#endif
#define PH(n) ((PHMASK >> (n)) & 1)
__global__ void __launch_bounds__(NTHREADS, 2) hymba_fwd(Params P) {
    extern __shared__ __attribute__((aligned(16))) unsigned char lds_raw[];
    LAS unsigned char* lds = (LAS unsigned char*)lds_raw;
    cg::grid_group grid = cg::this_grid();
    const int tid = threadIdx.x, lane = tid & 63, wave = __builtin_amdgcn_readfirstlane(tid >> 6), G = gridDim.x;
    unsigned char* ws = P.ws;
    bf16* WIN = (bf16*)(ws + WS_WIN); bf16* WOUT = (bf16*)(ws + WS_WOUT); bf16* WGU = (bf16*)(ws + WS_WGU); bf16* WDN = (bf16*)(ws + WS_WDN);
    bf16* XB = (bf16*)(ws + WS_XB); bf16* PROJ = (bf16*)(ws + WS_PROJ); bf16* MIXED = (bf16*)(ws + WS_MIXED); bf16* HB = (bf16*)(ws + WS_H); bf16* ACT = (bf16*)(ws + WS_ACT);

#if PH(0)
    p0_prologue(P, lds, tid, lane, wave, G);
#endif
    grid.sync();
#if PH(1)
    {
        pg8::Gemm g{XB, WIN, M, NPROJ, DM}; pg8::StaticOrder S; S.init(M, NPROJ, G, (int)blockIdx.x);
        pg8::EpiBf16<0> E{PROJ, NPROJ, nullptr, 0, 0, 1.f};
        pg8::gemm_phase<pg8::EpiBf16<0>, pg8::StaticOrder, true, true>(lds, g, S, E);
    }
    grid.sync();
#endif
#if PH(2)
    for (int u = blockIdx.x; u < 4 * NCH; u += G) {
#if !defined(NO_ATTN)
        if (u < 2 * NCH) attn_unit(P, lds, u >> 1, u & 1, tid, lane, wave);
#endif
#if !defined(NO_BST)
        if (u >= 2 * NCH) { const int v = u - 2 * NCH; bstate_unit(P, lds, v >> 1, v & 1, tid, lane, wave); }
#endif
    }
    grid.sync();
#endif
#if PH(3)
    p3_scan(P, tid, G);
#endif
    grid.sync();
#if PH(4)
    for (int u = blockIdx.x; u < 2 * NCH; u += G) ssd_unit(P, lds, u >> 1, u & 1, tid, lane, wave);
    grid.sync();
#endif
#if PH(5)
    {
        pg8::Gemm g{MIXED, WOUT, M, DM, DM}; pg8::StaticOrder S; S.init(M, DM, G, (int)blockIdx.x);
        pg8::EpiResF32 E{P.x_prompt, P.x_sample, MP / 256, P.out + O_Y, DM, ALPHA};
        pg8::gemm_phase<pg8::EpiResF32, pg8::StaticOrder, true, true>(lds, g, S, E);
    }
    grid.sync();
#endif
#if PH(6)
    ln_rows(P.out + O_Y, P.ln1_g, P.ln1_b, HB, nullptr, lane, wave, G);
    grid.sync();
#endif
#if PH(7)
    {
        pg8::Gemm g{HB, WGU, M, NGU, DM}; pg8::StaticOrder S; S.init(M, NGU, G, (int)blockIdx.x);
        pg8::EpiSwiglu E{ACT, DFF};
        pg8::gemm_phase<pg8::EpiSwiglu, pg8::StaticOrder, true, true>(lds, g, S, E);
    }
    grid.sync();
#endif
#if PH(8)
    {
        pg8::Gemm g{ACT, WDN, M, DM, DFF}; pg8::StaticOrder S; S.init(M, DM, G, (int)blockIdx.x);
        pg8::EpiResBf16In E{HB, P.out + O_Y, DM, ALPHA};
        pg8::gemm_phase<pg8::EpiResBf16In, pg8::StaticOrder, true, true>(lds, g, S, E);
    }
    grid.sync();
#endif
#if PH(9)
    ln_rows(P.out + O_Y, P.ln2_g, P.ln2_b, nullptr, P.out + O_Y, lane, wave, G);
#endif
}

extern "C" void kernel_launch(void* const* d_in, const int* in_sizes, int n_in, void* d_out, int out_size, void* d_ws, size_t ws_size, hipStream_t stream) {
    static int grid = 0;
    if (grid == 0) {
        if (n_in != 22 || (size_t)out_size != O_END || ws_size < WS_END) { fprintf(stderr, "kernel_launch: unexpected shapes: n_in %d out %d ws %zu (need %zu)\n", n_in, out_size, ws_size, (size_t)WS_END); grid = -1; return; }
        int dev = 0, cus = 0, per_cu = 0;
        hipGetDevice(&dev); hipDeviceGetAttribute(&cus, hipDeviceAttributeMultiprocessorCount, dev);
        hipFuncSetAttribute((const void*)hymba_fwd, hipFuncAttributeMaxDynamicSharedMemorySize, LDS_BYTES);
        hipOccupancyMaxActiveBlocksPerMultiprocessor(&per_cu, (const void*)hymba_fwd, NTHREADS, LDS_BYTES);
        if (per_cu < 1) { fprintf(stderr, "kernel_launch: occupancy query says %d blocks/CU\n", per_cu); per_cu = 1; }
        grid = cus * per_cu;
    }
    if (grid < 0) return;
    Params p{};
    const float** pp = (const float**)&p;
    for (int i = 0; i < 22; ++i) pp[i] = (const float*)d_in[i];
    p.out = (float*)d_out; p.ws = (unsigned char*)d_ws;
    void* args[] = {&p};
    hipError_t e = hipLaunchCooperativeKernel((const void*)hymba_fwd, dim3(grid), dim3(NTHREADS), args, LDS_BYTES, stream);
    if (e != hipSuccess) fprintf(stderr, "cooperative launch failed: %s (grid %d)\n", hipGetErrorString(e), grid);
}
```

```cpp
#include <hip/hip_runtime.h>
#include <hip/hip_cooperative_groups.h>
#include <cstdio>
#include <cstdint>
namespace cg = cooperative_groups;
namespace pg8 {
#define PG8_LAS __attribute__((address_space(3)))
typedef unsigned short bf16_t;
typedef short bf16x8 __attribute__((ext_vector_type(8)));
typedef float f32x4 __attribute__((ext_vector_type(4)));
typedef unsigned u32x4 __attribute__((ext_vector_type(4)));
constexpr int BM = 256, BK = 64, HALF = 128, HTB = HALF * BK * 2  , STAGE_BYTES = 8 * HTB, NXCD = 8, WGM = 8;

__host__ __device__ __forceinline__ int lds_byte(int r, int c) { const int st = (r >> 4) * 2 + (c >> 5), rr = r & 15, cc = c & 31, ob = rr * 64 + cc * 2; return st * 1024 + (ob ^ (((ob >> 9) & 1) << 5)); }
__host__ __device__ __forceinline__ void stage_rc(int b, int& R, int& C) { const int st = b / 1024, sb = b % 1024, swz = sb ^ (((sb >> 9) & 1) << 5); R = (st >> 1) * 16 + swz / 64; C = (st & 1) * 32 + (swz % 64) / 2; }
__host__ __device__ __forceinline__ int perm32(int rho) { const int n = rho >> 4, i = rho & 15; return 8 * (i >> 2) + 4 * n + (i & 3); }

struct Unit { int pm, pn; };
struct Gemm { const bf16_t* A; const bf16_t* Bt; int M, N, K; };

struct StaticOrder {
    int nM, nN, nwg, G, c;
    __host__ __device__ void init(int M, int N, int G_, int c_) { nM = M / BM; nN = N / BM; nwg = nM * nN; G = G_; c = c_; }
    __host__ __device__ bool next(int i, Unit& u) const {
        const long L = (long)i * G + c; if (L >= nwg) return false;
        int wgid = (int)L; { const int q = nwg / NXCD, r = nwg % NXCD, xcd = wgid % NXCD, off = wgid / NXCD; wgid = (xcd < r ? xcd * (q + 1) : r * (q + 1) + (xcd - r) * q) + off; }
        const int nig = WGM * nN, gid = wgid / nig, fm = gid * WGM, gsz = (nM - fm) < WGM ? (nM - fm) : WGM;
        u.pm = fm + ((wgid % nig) % gsz); u.pn = (wgid % nig) / gsz; return true;
    }
    __device__ __forceinline__ void a_ready(const Unit&) const {}
    __device__ __forceinline__ void done(const Unit&) const {}
};

__device__ __forceinline__ unsigned cvt_pk_bf16(float lo, float hi) { unsigned r; asm volatile("v_cvt_pk_bf16_f32 %0, %1, %2" : "=v"(r) : "v"(lo), "v"(hi)); return r; }
typedef float f32x2 __attribute__((ext_vector_type(2)));
__device__ __forceinline__ f32x2 gelu_pk(f32x2 v) {
    const f32x2 av = __builtin_elementwise_abs(v), d = av * 0.2316418882f + 1.0f;
    f32x2 t; t.x = __builtin_amdgcn_rcpf(d.x); t.y = __builtin_amdgcn_rcpf(d.y);
    f32x2 q = t * 0.5307027145f + (-0.7265760135f); q = q * t + 0.7107068705f; q = q * t + (-0.142248368f); q = q * t + 0.127414796f; q = q * t;
    const f32x2 s = (v * v) * (-0.72134752044f);
    f32x2 e; e.x = __builtin_amdgcn_exp2f(s.x); e.y = __builtin_amdgcn_exp2f(s.y);
    const f32x2 m = v * (q * e), r = v - m;
    f32x2 o; o.x = v.x < 0.f ? m.x : r.x; o.y = v.y < 0.f ? m.y : r.y; return o;
}

template <int ACT  > struct EpiBf16 {
    static constexpr bool PERM = true, AFTER_DRAIN = false; static_assert(ACT == 0 || ACT == 1, "EpiBf16: ACT is 0 (none) or 1 (gelu_pk)");
    bf16_t* O; int ldc; const float* bias; int split_cols; size_t split_stride; float scale0;
    __device__ __forceinline__ void operator()(const f32x4 (&acc)[2][2][4][2], const Unit& u, int wr, int wc, int fr, int fq) const {
        const int row0 = u.pm * BM + wr * 64 + fr; int colt = u.pn * BM; bf16_t* base = O;
        float sc = 1.f; if (split_cols) { const int t = colt / split_cols; base += (size_t)t * split_stride; colt -= t * split_cols; if (t == 0) sc = scale0; }
        const int col0 = colt + wc * 32 + 8 * fq, bcol0 = u.pn * BM + wc * 32 + 8 * fq;
        f32x4 bv[2][2];
#pragma unroll
        for (int bj = 0; bj < 2; ++bj)
#pragma unroll
            for (int n = 0; n < 2; ++n) bv[bj][n] = bias ? *(const f32x4*)(bias + bcol0 + bj * HALF + 4 * n) : (f32x4){0.f, 0.f, 0.f, 0.f};
#pragma unroll
        for (int ai = 0; ai < 2; ++ai)
#pragma unroll
            for (int m = 0; m < 4; ++m) { bf16_t* rowp = base + (size_t)(row0 + ai * HALF + m * 16) * ldc + col0;
#pragma unroll
                for (int bj = 0; bj < 2; ++bj) { f32x4 v0 = acc[ai][bj][m][0] + bv[bj][0], v1 = acc[ai][bj][m][1] + bv[bj][1];
                    if (ACT == 1) { f32x2 a = gelu_pk((f32x2){v0[0], v0[1]}), b = gelu_pk((f32x2){v0[2], v0[3]}), c = gelu_pk((f32x2){v1[0], v1[1]}), d = gelu_pk((f32x2){v1[2], v1[3]});
                        v0 = (f32x4){a.x, a.y, b.x, b.y}; v1 = (f32x4){c.x, c.y, d.x, d.y}; }
                    v0 = v0 * sc; v1 = v1 * sc; u32x4 w; w.x = cvt_pk_bf16(v0[0], v0[1]); w.y = cvt_pk_bf16(v0[2], v0[3]); w.z = cvt_pk_bf16(v1[0], v1[1]); w.w = cvt_pk_bf16(v1[2], v1[3]);
                    *(u32x4*)(rowp + bj * HALF) = w; } }
    }
};
template <class Epi, class Sched, bool ALIGN_EPI = false, bool SP2 = false>
__device__ __forceinline__ void gemm_phase(PG8_LAS unsigned char* lds, const Gemm g, const Sched& S, const Epi& E) {
    int tid_o = threadIdx.x; asm volatile("" : "+v"(tid_o));
    const int tid = tid_o, wid = __builtin_amdgcn_readfirstlane(tid >> 6), lane = tid & 63, wr = wid >> 2, wc = wid & 3, fr = lane & 15, fq = lane >> 4;
    const int K = g.K, nt = K / BK;
    unsigned voffA[2], voffB[2];
#pragma unroll
    for (int i = 0; i < 2; ++i) { int R, C; stage_rc(tid * 16 + i * 8192, R, C); const int Rb = Epi::PERM ? ((R & ~31) + perm32(R & 31)) : R;
        voffA[i] = (unsigned)(R * K + C) * 2u; voffB[i] = (unsigned)(Rb * K + C) * 2u; }
    const size_t kstep = (size_t)(BK * 2);
    const size_t hstep = (size_t)HALF * K * 2;
    const size_t tstep = 2 * hstep;
    const unsigned ldsw = (unsigned)wid * 1024u;
    const int aoff = lds_byte(wr * 64 + fr, fq * 8), boff = lds_byte(wc * 32 + fr, fq * 8);
#define PG8_SA(b, h) (((b) * 2 + (h)) * HTB)
#define PG8_SB(b, h) ((4 + (b) * 2 + (h)) * HTB)
#define PG8_STAGE(bufoff, gbase, voff) do { _Pragma("unroll") for (int _i = 0; _i < 2; ++_i) \
        __builtin_amdgcn_global_load_lds((const unsigned*)((const char*)(gbase) + (voff)[_i]), (PG8_LAS unsigned*)(lds + (bufoff) + ldsw + _i * 8192), 16, 0, 0); } while (0)
#define PG8_LDA(dst, b, h) do { _Pragma("unroll") for (int m = 0; m < 4; ++m) _Pragma("unroll") for (int k = 0; k < 2; ++k) dst[m][k] = *(const PG8_LAS bf16x8*)(lds + PG8_SA(b, h) + aoff + m * 2048 + k * 1024); } while (0)
#define PG8_LDB(dst, b, h) do { _Pragma("unroll") for (int n = 0; n < 2; ++n) _Pragma("unroll") for (int k = 0; k < 2; ++k) dst[n][k] = *(const PG8_LAS bf16x8*)(lds + PG8_SB(b, h) + boff + n * 2048 + k * 1024); } while (0)
#define PG8_MMA(ai, bj, At, Bt) do { __builtin_amdgcn_s_setprio(1); _Pragma("unroll") for (int m = 0; m < 4; ++m) _Pragma("unroll") for (int n = 0; n < 2; ++n) _Pragma("unroll") for (int k = 0; k < 2; ++k) \
        acc[ai][bj][m][n] = __builtin_amdgcn_mfma_f32_16x16x32_bf16(Bt[n][k], At[m][k], acc[ai][bj][m][n], 0, 0, 0); __builtin_amdgcn_s_setprio(0); } while (0)
#define PG8_WAIT_V(n) asm volatile("s_waitcnt vmcnt(" #n ")" ::: "memory")
#define PG8_WAIT_L(n) asm volatile("s_waitcnt lgkmcnt(" #n ")" ::: "memory")
#define PG8_BAR __builtin_amdgcn_s_barrier()
#define PG8_SCHED __builtin_amdgcn_sched_barrier(0)
    Unit cur, nxt; int ui = 0;
    if (!S.next(0, cur)) return;
    f32x4 acc[2][2][4][2];
#pragma unroll
    for (int a = 0; a < 2; ++a)
#pragma unroll
        for (int b = 0; b < 2; ++b)
#pragma unroll
            for (int m = 0; m < 4; ++m)
#pragma unroll
                for (int n = 0; n < 2; ++n) acc[a][b][m][n] = (f32x4){0.f, 0.f, 0.f, 0.f};
    bf16x8 At[4][2], B0[2][2], B1[2][2];
    const char* cA = (const char*)g.A + (size_t)cur.pm * tstep; const char* cB = (const char*)g.Bt + (size_t)cur.pn * tstep;
    S.a_ready(cur);
    if constexpr (SP2) {
        PG8_STAGE(PG8_SB(0, 0), cB, voffB); PG8_STAGE(PG8_SB(0, 1), cB + hstep, voffB); PG8_STAGE(PG8_SA(0, 0), cA, voffA); PG8_STAGE(PG8_SA(0, 1), cA + hstep, voffA);
        if (wr == 1) PG8_BAR;
        PG8_WAIT_V(2); PG8_BAR;
        PG8_STAGE(PG8_SB(1, 0), cB + kstep, voffB); PG8_STAGE(PG8_SA(1, 0), cA + kstep, voffA); PG8_STAGE(PG8_SB(1, 1), cB + hstep + kstep, voffB);
        PG8_WAIT_V(6); PG8_BAR;
    } else {
        PG8_STAGE(PG8_SB(0, 0), cB, voffB); PG8_STAGE(PG8_SA(0, 0), cA, voffA); PG8_STAGE(PG8_SB(0, 1), cB + hstep, voffB); PG8_STAGE(PG8_SA(0, 1), cA + hstep, voffA);
        if (wr == 1) PG8_BAR;
        PG8_WAIT_V(4); PG8_BAR;
        PG8_STAGE(PG8_SB(1, 0), cB + kstep, voffB); PG8_STAGE(PG8_SA(1, 0), cA + kstep, voffA); PG8_STAGE(PG8_SB(1, 1), cB + hstep + kstep, voffB);
        PG8_WAIT_V(6); PG8_BAR;
    }
    for (;;) {
        const bool has_next = S.next(ui + 1, nxt);
        const char* nA = has_next ? (const char*)g.A + (size_t)nxt.pm * tstep : cA; const char* nB = has_next ? (const char*)g.Bt + (size_t)nxt.pn * tstep : cB;
        for (int t = 0; t < nt; t += 2) {
            const bool last = (t == nt - 2);
            const char* a1 = cA + (size_t)(t + 1) * kstep;
            const char* a2 = last ? nA : cA + (size_t)(t + 2) * kstep; const char* b2 = last ? nB : cB + (size_t)(t + 2) * kstep;
            const char* a3 = a2 + kstep; const char* b3 = b2 + kstep;
            if (last && has_next) S.a_ready(nxt);
            if constexpr (SP2) {
            PG8_LDB(B0, 0, 0); PG8_LDB(B1, 0, 1); PG8_SCHED; PG8_LDA(At, 0, 0); PG8_STAGE(PG8_SA(1, 1), a1 + hstep, voffA);
            PG8_WAIT_V(8); PG8_WAIT_L(0); PG8_BAR; PG8_MMA(0, 0, At, B0); PG8_MMA(0, 1, At, B1); PG8_BAR; PG8_SCHED;
            PG8_LDA(At, 0, 1); PG8_STAGE(PG8_SB(0, 0), b2, voffB); PG8_STAGE(PG8_SB(0, 1), b2 + hstep, voffB); PG8_STAGE(PG8_SA(0, 0), a2, voffA);
            PG8_WAIT_V(8); PG8_WAIT_L(0); PG8_BAR; PG8_MMA(1, 0, At, B0); PG8_MMA(1, 1, At, B1); PG8_BAR; PG8_SCHED;
            PG8_LDB(B0, 1, 0); PG8_LDB(B1, 1, 1); PG8_SCHED; PG8_LDA(At, 1, 0); PG8_STAGE(PG8_SA(0, 1), a2 + hstep, voffA);
            PG8_WAIT_V(8); PG8_WAIT_L(0); PG8_BAR; PG8_MMA(0, 0, At, B0); PG8_MMA(0, 1, At, B1); PG8_BAR; PG8_SCHED;
            PG8_LDA(At, 1, 1); PG8_STAGE(PG8_SB(1, 0), b3, voffB); PG8_STAGE(PG8_SB(1, 1), b3 + hstep, voffB); PG8_STAGE(PG8_SA(1, 0), a3, voffA);
            PG8_WAIT_V(8); PG8_WAIT_L(0); PG8_BAR; PG8_MMA(1, 0, At, B0); PG8_MMA(1, 1, At, B1); PG8_BAR; PG8_SCHED;
            } else {
            PG8_LDB(B0, 0, 0); PG8_SCHED; PG8_LDA(At, 0, 0); PG8_STAGE(PG8_SA(1, 1), a1 + hstep, voffA);
            PG8_WAIT_L(8); PG8_BAR; PG8_WAIT_L(0); PG8_MMA(0, 0, At, B0); PG8_BAR; PG8_SCHED;
            PG8_LDB(B1, 0, 1); PG8_STAGE(PG8_SB(0, 0), b2, voffB);
            PG8_BAR; PG8_WAIT_L(0); PG8_MMA(0, 1, At, B1); PG8_BAR;
            PG8_LDA(At, 0, 1); PG8_STAGE(PG8_SA(0, 0), a2, voffA);
            PG8_BAR; PG8_WAIT_L(0); PG8_MMA(1, 0, At, B0); PG8_BAR; PG8_SCHED;
            PG8_STAGE(PG8_SB(0, 1), b2 + hstep, voffB);
            PG8_WAIT_V(6); PG8_BAR; PG8_MMA(1, 1, At, B1); PG8_BAR;
            PG8_LDB(B0, 1, 0); PG8_SCHED; PG8_LDA(At, 1, 0); PG8_STAGE(PG8_SA(0, 1), a2 + hstep, voffA);
            PG8_WAIT_L(8); PG8_BAR; PG8_WAIT_L(0); PG8_MMA(0, 0, At, B0); PG8_BAR; PG8_SCHED;
            PG8_LDB(B1, 1, 1); PG8_STAGE(PG8_SB(1, 0), b3, voffB);
            PG8_BAR; PG8_WAIT_L(0); PG8_MMA(0, 1, At, B1); PG8_BAR;
            PG8_LDA(At, 1, 1); PG8_STAGE(PG8_SA(1, 0), a3, voffA);
            PG8_BAR; PG8_WAIT_L(0); PG8_MMA(1, 0, At, B0); PG8_BAR; PG8_SCHED;
            PG8_STAGE(PG8_SB(1, 1), b3 + hstep, voffB);
            PG8_WAIT_V(6); PG8_BAR; PG8_MMA(1, 1, At, B1); PG8_BAR;
            }
        }
        if constexpr (ALIGN_EPI) { if (wr == 0) PG8_BAR; }
        if constexpr (!Epi::AFTER_DRAIN) { E(acc, cur, wr, wc, fr, fq); S.done(cur); }
        if (!has_next) break;
#pragma unroll
        for (int a = 0; a < 2; ++a)
#pragma unroll
            for (int b = 0; b < 2; ++b)
#pragma unroll
                for (int m = 0; m < 4; ++m)
#pragma unroll
                    for (int n = 0; n < 2; ++n) acc[a][b][m][n] = (f32x4){0.f, 0.f, 0.f, 0.f};
        cur = nxt; cA = nA; cB = nB; ++ui;
        if constexpr (ALIGN_EPI) { if (wr == 1) PG8_BAR; }
    }
    PG8_WAIT_V(0);
    if constexpr (!ALIGN_EPI) { if (wr == 0) PG8_BAR; }
    PG8_BAR;
    if constexpr (Epi::AFTER_DRAIN) { E.fused(acc, cur, wr, wc, fr, fq, lds, wid, lane); S.done(cur); }
#undef PG8_SA
#undef PG8_SB
#undef PG8_STAGE
#undef PG8_LDA
#undef PG8_LDB
#undef PG8_MMA
#undef PG8_WAIT_V
#undef PG8_WAIT_L
#undef PG8_BAR
#undef PG8_SCHED
}
}
namespace pg8 {
struct EpiResF32 {
    static constexpr bool PERM = false, AFTER_DRAIN = false;
    const float* xp; const float* xs; int split_pm; float* out; int ldc; float alpha;
    __device__ __forceinline__ void operator()(const f32x4 (&acc)[2][2][4][2], const Unit& u, int wr, int wc, int fr, int fq) const {
        const int col0 = u.pn * BM + wc * 32 + 4 * fq;
        const float* bp = (u.pm < split_pm) ? xp + (size_t)u.pm * BM * ldc : xs + (size_t)(u.pm - split_pm) * BM * ldc;
        float* op = out + (size_t)u.pm * BM * ldc;
#pragma unroll
        for (int ai = 0; ai < 2; ++ai)
#pragma unroll
            for (int m = 0; m < 4; ++m) { const size_t off = (size_t)(ai * HALF + wr * 64 + m * 16 + fr) * ldc + col0;
#pragma unroll
                for (int bj = 0; bj < 2; ++bj)
#pragma unroll
                    for (int n = 0; n < 2; ++n) { const f32x4 bs = *(const f32x4*)(bp + off + bj * HALF + n * 16); const f32x4 o = bs * alpha + acc[ai][bj][m][n]; *(f32x4*)(op + off + bj * HALF + n * 16) = o; }
                if (m & 1) asm volatile("" ::: "memory"); }
    }
};
struct EpiResBf16In {
    static constexpr bool PERM = false, AFTER_DRAIN = false;
    const bf16_t* h; float* out; int ldc; float alpha;
    __device__ __forceinline__ void operator()(const f32x4 (&acc)[2][2][4][2], const Unit& u, int wr, int wc, int fr, int fq) const {
        typedef unsigned u32x2v __attribute__((ext_vector_type(2)));
        const int col0 = u.pn * BM + wc * 32 + 4 * fq;
#pragma unroll
        for (int ai = 0; ai < 2; ++ai)
#pragma unroll
            for (int m = 0; m < 4; ++m) { const size_t off = (size_t)(u.pm * BM + ai * HALF + wr * 64 + m * 16 + fr) * ldc + col0;
#pragma unroll
                for (int bj = 0; bj < 2; ++bj)
#pragma unroll
                    for (int n = 0; n < 2; ++n) { const u32x2v hb = *(const u32x2v*)(h + off + bj * HALF + n * 16);
                        f32x4 bs; bs[0] = __uint_as_float(hb.x << 16); bs[1] = __uint_as_float(hb.x & 0xffff0000u); bs[2] = __uint_as_float(hb.y << 16); bs[3] = __uint_as_float(hb.y & 0xffff0000u);
                        const f32x4 o = bs * alpha + acc[ai][bj][m][n]; *(f32x4*)(out + off + bj * HALF + n * 16) = o; }
                if (m & 1) asm volatile("" ::: "memory"); }
    }
};
struct EpiSwiglu {
    static constexpr bool PERM = true, AFTER_DRAIN = false;
    bf16_t* O; int ldc;
    __device__ __forceinline__ void operator()(const f32x4 (&acc)[2][2][4][2], const Unit& u, int wr, int wc, int fr, int fq) const {
        const int row0 = u.pm * BM + wr * 64 + fr; const int col0 = u.pn * HALF + wc * 32 + 8 * fq;
#pragma unroll
        for (int ai = 0; ai < 2; ++ai)
#pragma unroll
            for (int m = 0; m < 4; ++m) { bf16_t* rowp = O + (size_t)(row0 + ai * HALF + m * 16) * ldc + col0;
                float v[8];
#pragma unroll
                for (int n = 0; n < 2; ++n)
#pragma unroll
                    for (int e = 0; e < 4; ++e) { const float g = acc[ai][0][m][n][e], up = acc[ai][1][m][n][e]; v[n * 4 + e] = g * __builtin_amdgcn_rcpf(1.0f + __expf(-g)) * up; }
                u32x4 w; w.x = cvt_pk_bf16(v[0], v[1]); w.y = cvt_pk_bf16(v[2], v[3]); w.z = cvt_pk_bf16(v[4], v[5]); w.w = cvt_pk_bf16(v[6], v[7]);
                *(u32x4*)rowp = w; }
    }
};
}
#define LAS __attribute__((address_space(3)))
typedef unsigned short bf16;
typedef short bf16x8 __attribute__((ext_vector_type(8)));
typedef short s16x4 __attribute__((ext_vector_type(4)));
typedef float f32x4 __attribute__((ext_vector_type(4)));
typedef float f32x16 __attribute__((ext_vector_type(16)));
typedef unsigned u32x4 __attribute__((ext_vector_type(4)));
typedef unsigned u32x2 __attribute__((ext_vector_type(2)));

constexpr int NWAVES = 8, NTHREADS = 512;
constexpr int DM = 1024, BATCH = 8, SEQ = 4096, DEC_T = 64;
constexpr int MP = BATCH * SEQ, MS = BATCH * DEC_T, M = MP + MS;
constexpr int NCH_P = MP / 64, NCH = M / 64;
constexpr int IN_COLS = 2312, NPROJ = 2304, DFF = 2816, NGU = 2 * DFF;
constexpr int PC_Z = 0, PC_XS = 512, PC_B = 1024, PC_C = 1280, PC_Q = 1536, PC_K = 2048, PC_V = 2176;
constexpr float LN_EPS = 1e-5f, RMS_EPS = 1e-5f, ALPHA = 1.189207115002721f;
constexpr size_t MiB = 1u << 20;
constexpr size_t WS_WIN = 2 * MiB, WS_WOUT = 7 * MiB, WS_WGU = 9 * MiB, WS_WDN = 20 * MiB, WS_DT = 26 * MiB, WS_CDEC = 28 * MiB;
constexpr size_t WS_XB = 32 * MiB, WS_MIXED = WS_XB, WS_PROJ = 97 * MiB, WS_BSTATE = 244 * MiB, WS_SPREV = 374 * MiB, WS_H = 97 * MiB, WS_ACT = 162 * MiB, WS_END = 439 * MiB;
static_assert(WS_XB + (size_t)M * DM * 2 <= WS_PROJ && WS_PROJ + (size_t)M * NPROJ * 2 <= WS_BSTATE && WS_BSTATE + (size_t)NCH * 65536 * 4 <= WS_SPREV && WS_SPREV + (size_t)NCH * 65536 * 2 <= WS_END, "ws map");
static_assert(WS_H + (size_t)M * DM * 2 <= WS_ACT && WS_ACT + (size_t)M * DFF * 2 <= WS_END, "ws map 2");
constexpr size_t O_Y = 0, O_CONVP = (size_t)M * DM, O_SSMP = O_CONVP + 24576, O_KP = O_SSMP + 524288, O_VP = O_KP + 131072, O_CONVS = O_VP + 131072, O_SSMS = O_CONVS + 24576, O_KS = O_SSMS + 524288, O_VS = O_KS + 131072, O_END = O_VS + 131072;
constexpr int LDS_BYTES = 147456;

struct Params {
    const float *x_prompt, *x_sample, *state_conv, *state_ssm, *cache_k, *cache_v, *w_in, *conv_w, *conv_b, *dt_bias, *a_log, *d_skip, *ssm_norm_w, *attn_sinks,
                *w_out, *ln1_g, *ln1_b, *w_gate, *w_up, *w_down, *ln2_g, *ln2_b;
    float* out; unsigned char* ws;
};

__device__ __forceinline__ float bf2f(unsigned short h) { return __uint_as_float((unsigned)h << 16); }
__device__ __forceinline__ unsigned pk2(float lo, float hi) { return pg8::cvt_pk_bf16(lo, hi); }
__device__ __forceinline__ float wave_sum(float v) {
#pragma unroll
    for (int o = 1; o < 64; o <<= 1) v += __shfl_xor(v, o);
    return v;
}
__device__ __forceinline__ float silu_f(float v) { return v * __builtin_amdgcn_rcpf(1.0f + __expf(-v)); }
__device__ __forceinline__ void unpack8(const u32x4 w, float (&f)[8]) {
    f[0] = __uint_as_float(w.x << 16); f[1] = __uint_as_float(w.x & 0xffff0000u); f[2] = __uint_as_float(w.y << 16); f[3] = __uint_as_float(w.y & 0xffff0000u);
    f[4] = __uint_as_float(w.z << 16); f[5] = __uint_as_float(w.z & 0xffff0000u); f[6] = __uint_as_float(w.w << 16); f[7] = __uint_as_float(w.w & 0xffff0000u);
}

__device__ __forceinline__ void p0_item(const float* W, int ldw, int k0, int nsrc0, bf16* WT, int K, int drow0, LAS float* scr, int lane) {
#pragma unroll 8
    for (int i = 0; i < 32; ++i) { const int kk = 2 * i + (lane >> 5); scr[kk * 33 + (lane & 31)] = W[(size_t)(k0 + kk) * ldw + nsrc0 + (lane & 31)]; }
    asm volatile("s_waitcnt lgkmcnt(0)" ::: "memory");
    const int c = lane & 7;
#pragma unroll
    for (int j = 0; j < 4; ++j) { const int n = (lane >> 3) + 8 * j; const LAS float* s = scr + (8 * c) * 33 + n;
        u32x4 o; o.x = pk2(s[0 * 33], s[1 * 33]); o.y = pk2(s[2 * 33], s[3 * 33]); o.z = pk2(s[4 * 33], s[5 * 33]); o.w = pk2(s[6 * 33], s[7 * 33]);
        *(u32x4*)(WT + (size_t)(drow0 + n) * K + k0 + 8 * c) = o; }
    asm volatile("s_waitcnt lgkmcnt(0)" ::: "memory");
}

__device__ __forceinline__ void p0_prologue(const Params& P, LAS unsigned char* lds, int tid, int lane, int wave, int G) {
    unsigned char* ws = P.ws;
    bf16* WIN = (bf16*)(ws + WS_WIN); bf16* WOUT = (bf16*)(ws + WS_WOUT); bf16* WGU = (bf16*)(ws + WS_WGU); bf16* WDN = (bf16*)(ws + WS_WDN);
    bf16* XB = (bf16*)(ws + WS_XB); float* DT = (float*)(ws + WS_DT);
    LAS float* scr = (LAS float*)(lds + wave * 8448);
    LAS float* wdt = (LAS float*)(lds + 73728);
    for (int i = tid; i < 8192; i += NTHREADS) { const int k = i >> 3, h = i & 7; wdt[h * 1024 + k] = P.w_in[(size_t)k * IN_COLS + 1536 + h]; }
    const int gw = blockIdx.x * NWAVES + wave, NGW = G * NWAVES;
    constexpr int I_IN = 16 * 72, I_OUT = 16 * 32, I_GU = 16 * 176, I_DN = 44 * 32, NITEMS = I_IN + I_OUT + I_GU + I_DN;
    for (int it = gw; it < NITEMS; it += NGW) {
        int r = it;
        if (r < I_IN) { const int kb = r / 72, nb = r % 72, n0 = 32 * nb; p0_item(P.w_in, IN_COLS, 64 * kb, n0 + (n0 >= 1536 ? 8 : 0), WIN, DM, n0, scr, lane); continue; } r -= I_IN;
        if (r < I_OUT) { const int kb = r / 32, nb = r % 32; p0_item(P.w_out, DM, 64 * kb, 32 * nb, WOUT, DM, 32 * nb, scr, lane); continue; } r -= I_OUT;
        if (r < I_GU) { const int kb = r / 176, nb = r % 176, t = nb >> 3, s = (nb >> 2) & 1, i0 = 32 * (nb & 3); p0_item(s ? P.w_up : P.w_gate, DFF, 64 * kb, 128 * t + i0, WGU, DM, 32 * nb, scr, lane); continue; } r -= I_GU;
        { const int kb = r / 32, nb = r % 32; p0_item(P.w_down, DM, 64 * kb, 32 * nb, WDN, DFF, 32 * nb, scr, lane); }
    }
    __syncthreads();
    float bias = 0.f; if (lane < 8) bias = P.dt_bias[lane];
    for (int m = gw; m < M; m += NGW) {
        const float* xrow = (m < MP) ? P.x_prompt + (size_t)m * DM : P.x_sample + (size_t)(m - MP) * DM;
        f32x4 v[4];
#pragma unroll
        for (int j = 0; j < 4; ++j) v[j] = *(const f32x4*)(xrow + 4 * lane + 256 * j);
        unsigned long long* o8 = (unsigned long long*)(XB + (size_t)m * DM) + lane;
#pragma unroll
        for (int j = 0; j < 4; ++j) o8[64 * j] = (unsigned long long)pk2(v[j][0], v[j][1]) | ((unsigned long long)pk2(v[j][2], v[j][3]) << 32);
        float mine = 0.f;
#pragma unroll
        for (int h = 0; h < 8; ++h) { float a = 0.f;
#pragma unroll
            for (int j = 0; j < 4; ++j) { const f32x4 w = *(const LAS f32x4*)(wdt + h * 1024 + 4 * lane + 256 * j); a += v[j][0] * w[0] + v[j][1] * w[1] + v[j][2] * w[2] + v[j][3] * w[3]; }
            a = wave_sum(a); if (lane == h) mine = a; }
        if (lane < 8) { const float xx = mine + bias; DT[(size_t)m * 8 + lane] = (xx > 20.f) ? xx : log1pf(__expf(xx)); }
    }
}

__device__ __forceinline__ void conv8x4(const Params& P, const bf16* PROJ, int cid, int pcol, int cch, int t0, float (&o)[4][8]) {
    const bool sample = cid >= NCH_P; const bool has_prev = (!sample) && ((cid & 63) != 0);
    const size_t m0 = (size_t)cid * 64;
    float xin[7][8];
#pragma unroll
    for (int rr = 0; rr < 7; ++rr) { const int lt = t0 - 3 + rr;
        if (lt >= 0 || has_prev) { const u32x4 w = *(const u32x4*)(PROJ + (size_t)((long)m0 + lt) * NPROJ + pcol); unpack8(w, xin[rr]); }
        else if (sample) { const float* sc = P.state_conv + ((size_t)(cid - NCH_P) * 3 + (lt + 3)) * 1024 + cch; const f32x4 a = *(const f32x4*)sc, b = *(const f32x4*)(sc + 4);
            xin[rr][0] = a[0]; xin[rr][1] = a[1]; xin[rr][2] = a[2]; xin[rr][3] = a[3]; xin[rr][4] = b[0]; xin[rr][5] = b[1]; xin[rr][6] = b[2]; xin[rr][7] = b[3]; }
        else {
#pragma unroll
            for (int e = 0; e < 8; ++e) xin[rr][e] = 0.f; } }
    float cw[4][8], cb[8];
#pragma unroll
    for (int i = 0; i < 4; ++i) { const f32x4 a = *(const f32x4*)(P.conv_w + i * 1024 + cch), b = *(const f32x4*)(P.conv_w + i * 1024 + cch + 4);
        cw[i][0] = a[0]; cw[i][1] = a[1]; cw[i][2] = a[2]; cw[i][3] = a[3]; cw[i][4] = b[0]; cw[i][5] = b[1]; cw[i][6] = b[2]; cw[i][7] = b[3]; }
    { const f32x4 a = *(const f32x4*)(P.conv_b + cch), b = *(const f32x4*)(P.conv_b + cch + 4); cb[0] = a[0]; cb[1] = a[1]; cb[2] = a[2]; cb[3] = a[3]; cb[4] = b[0]; cb[5] = b[1]; cb[6] = b[2]; cb[7] = b[3]; }
#pragma unroll
    for (int tt = 0; tt < 4; ++tt)
#pragma unroll
        for (int e = 0; e < 8; ++e) { float a = cb[e];
#pragma unroll
            for (int i = 0; i < 4; ++i) a += cw[i][e] * xin[tt + i][e];
            o[tt][e] = silu_f(a); }
}

constexpr int KS_STR = 72, VT_STR = 200;
__device__ __forceinline__ void attn_unit(const Params& P, LAS unsigned char* lds, int cid, int kv, int tid, int lane, int wave) {
    asm volatile("" : "+v"(tid), "+v"(lane));
    const bf16* PROJ = (const bf16*)(P.ws + WS_PROJ); bf16* MIXED = (bf16*)(P.ws + WS_MIXED);
    LAS bf16* Ks = (LAS bf16*)lds; LAS bf16* VT = (LAS bf16*)(lds + 192 * KS_STR * 2);
    const bool sample = cid >= NCH_P; const int c = cid & 63; const size_t m0 = (size_t)cid * 64;
    for (int idx = tid; idx < 1536; idx += NTHREADS) { const int j = idx >> 3, ch = idx & 7;
        u32x4 k8 = (u32x4){0u, 0u, 0u, 0u}, v8 = (u32x4){0u, 0u, 0u, 0u};
        if (sample && j < 128) { const size_t o = (((size_t)(cid - NCH_P) * 128 + j) * 2 + kv) * 64 + ch * 8;
            const f32x4 a = *(const f32x4*)(P.cache_k + o), b = *(const f32x4*)(P.cache_k + o + 4), cc = *(const f32x4*)(P.cache_v + o), d = *(const f32x4*)(P.cache_v + o + 4);
            k8.x = pk2(a[0], a[1]); k8.y = pk2(a[2], a[3]); k8.z = pk2(b[0], b[1]); k8.w = pk2(b[2], b[3]);
            v8.x = pk2(cc[0], cc[1]); v8.y = pk2(cc[2], cc[3]); v8.z = pk2(d[0], d[1]); v8.w = pk2(d[2], d[3]); }
        else if (sample || (c * 64 - 128 + j >= 0)) { const bf16* rp = PROJ + (size_t)((long)m0 - 128 + j) * NPROJ + kv * 64 + ch * 8; k8 = *(const u32x4*)(rp + PC_K); v8 = *(const u32x4*)(rp + PC_V); }
        *(LAS u32x4*)(Ks + j * KS_STR + ch * 8) = k8;
        LAS bf16* vp = VT + (ch * 8) * VT_STR + j;
        vp[0 * VT_STR] = (bf16)(v8.x & 0xffff); vp[1 * VT_STR] = (bf16)(v8.x >> 16); vp[2 * VT_STR] = (bf16)(v8.y & 0xffff); vp[3 * VT_STR] = (bf16)(v8.y >> 16);
        vp[4 * VT_STR] = (bf16)(v8.z & 0xffff); vp[5 * VT_STR] = (bf16)(v8.z >> 16); vp[6 * VT_STR] = (bf16)(v8.w & 0xffff); vp[7 * VT_STR] = (bf16)(v8.w >> 16); }
    __syncthreads();
    const int r = wave >> 1, th = wave & 1, hq = kv * 4 + r, l31 = lane & 31, hh = lane >> 5; int tq = 32 * th + l31; asm volatile("" : "+v"(tq));
    const bf16* qp = PROJ + (m0 + tq) * NPROJ + PC_Q + hq * 64 + 8 * hh;
    bf16x8 qf[4];
#pragma unroll
    for (int ks = 0; ks < 4; ++ks) qf[ks] = *(const bf16x8*)(qp + 16 * ks);
    f32x16 sacc[6];
#pragma unroll
    for (int kt = 0; kt < 6; ++kt) {
#pragma unroll
        for (int i = 0; i < 16; ++i) sacc[kt][i] = 0.f;
#pragma unroll
        for (int ks = 0; ks < 4; ++ks) { const bf16x8 a = *(const LAS bf16x8*)(Ks + (32 * kt + l31) * KS_STR + 16 * ks + 8 * hh); sacc[kt] = __builtin_amdgcn_mfma_f32_32x32x16_bf16(a, qf[ks], sacc[kt], 0, 0, 0); }
        __builtin_amdgcn_sched_barrier(0); }
    const float slope = exp2f(-(float)(hq + 1)), sink = P.attn_sinks[hq];
    float mx = sink;
#pragma unroll
    for (int kt = 0; kt < 6; ++kt) { const bool valid = sample || (2 * c + kt >= 4);
#pragma unroll
        for (int i = 0; i < 16; ++i) { const int key = 32 * kt + (i & 3) + 8 * (i >> 2) + 4 * hh; const float dist = fabsf((float)(128 + tq - key));
            const float s = valid ? (sacc[kt][i] * 0.125f - slope * dist) : -INFINITY; sacc[kt][i] = s; mx = fmaxf(mx, s); }
        __builtin_amdgcn_sched_barrier(0); }
    mx = fmaxf(mx, __shfl_xor(mx, 32));
    float sum = 0.f;
#pragma unroll
    for (int kt = 0; kt < 6; ++kt)
#pragma unroll
        for (int i = 0; i < 16; ++i) { const float p = __expf(sacc[kt][i] - mx); sacc[kt][i] = p; sum += p; }
    sum += __shfl_xor(sum, 32);
    const float inv = 1.0f / (sum + __expf(sink - mx));
    f32x16 oacc[2];
#pragma unroll
    for (int d2 = 0; d2 < 2; ++d2)
#pragma unroll
        for (int i = 0; i < 16; ++i) oacc[d2][i] = 0.f;
#pragma unroll
    for (int kt = 0; kt < 6; ++kt)
#pragma unroll
        for (int s2 = 0; s2 < 2; ++s2) {
            union { u32x4 u; bf16x8 v; } pf;
            pf.u.x = pk2(sacc[kt][8 * s2 + 0], sacc[kt][8 * s2 + 1]); pf.u.y = pk2(sacc[kt][8 * s2 + 2], sacc[kt][8 * s2 + 3]);
            pf.u.z = pk2(sacc[kt][8 * s2 + 4], sacc[kt][8 * s2 + 5]); pf.u.w = pk2(sacc[kt][8 * s2 + 6], sacc[kt][8 * s2 + 7]);
#pragma unroll
            for (int d2 = 0; d2 < 2; ++d2) { const LAS bf16* vp = VT + (32 * d2 + l31) * VT_STR + 32 * kt + 16 * s2 + 4 * hh;
                union { u32x4 u; bf16x8 v; } af; const u32x2 lo = *(const LAS u32x2*)vp, hi = *(const LAS u32x2*)(vp + 8); af.u.x = lo.x; af.u.y = lo.y; af.u.z = hi.x; af.u.w = hi.y;
                oacc[d2] = __builtin_amdgcn_mfma_f32_32x32x16_bf16(af.v, pf.v, oacc[d2], 0, 0, 0); }
            __builtin_amdgcn_sched_barrier(0); }
    bf16* op = MIXED + (m0 + tq) * DM + 512 + hq * 64 + 4 * hh;
#pragma unroll
    for (int d2 = 0; d2 < 2; ++d2)
#pragma unroll
        for (int rg = 0; rg < 4; ++rg) { u32x2 w; w.x = pk2(oacc[d2][4 * rg] * inv, oacc[d2][4 * rg + 1] * inv); w.y = pk2(oacc[d2][4 * rg + 2] * inv, oacc[d2][4 * rg + 3] * inv);
            *(u32x2*)(op + 32 * d2 + 8 * rg) = w; }
    __syncthreads();
}

constexpr int XT_STR = 72, BM_STR = 136, CB_STR = 68;
__device__ __forceinline__ float wave_incl_scan(float v, int lane) {
#pragma unroll
    for (int o = 1; o < 64; o <<= 1) { const float t = __shfl_up(v, o); if (lane >= o) v += t; }
    return v;
}
__device__ __forceinline__ void bstate_unit(const Params& P, LAS unsigned char* lds, int cid, int g, int tid, int lane, int wave) {
    asm volatile("" : "+v"(tid), "+v"(lane));
    const bf16* PROJ = (const bf16*)(P.ws + WS_PROJ); const float* DT = (const float*)(P.ws + WS_DT); float* CDEC = (float*)(P.ws + WS_CDEC); float* BST = (float*)(P.ws + WS_BSTATE);
    LAS bf16* xsT = (LAS bf16*)lds;
    LAS bf16* BmT = (LAS bf16*)(lds + 256 * XT_STR * 2);
    LAS float* wsc = (LAS float*)(lds + 256 * XT_STR * 2 + 128 * XT_STR * 2);
    const size_t m0 = (size_t)cid * 64;
    if (wave < 4) { const int h = 4 * g + wave; const float dt = DT[(m0 + lane) * 8 + h]; const float a = -__expf(P.a_log[h]);
        const float cum = wave_incl_scan(dt * a, lane); const float tot = __shfl(cum, 63);
        wsc[wave * 64 + lane] = dt * __expf(tot - cum); if (lane == 63) CDEC[cid * 8 + h] = __expf(tot); }
    __syncthreads();
    { const int cg8 = tid & 31, seg = tid >> 5, t0 = 4 * seg; float o[4][8];
        conv8x4(P, PROJ, cid, PC_XS + 256 * g + 8 * cg8, 256 * g + 8 * cg8, t0, o);
        const int hh = cg8 >> 3; const f32x4 w4 = *(const LAS f32x4*)(wsc + hh * 64 + t0);
#pragma unroll
        for (int e = 0; e < 8; ++e) { u32x2 w; w.x = pk2(o[0][e] * w4[0], o[1][e] * w4[1]); w.y = pk2(o[2][e] * w4[2], o[3][e] * w4[3]); *(LAS u32x2*)(xsT + (8 * cg8 + e) * XT_STR + t0) = w; } }
    if (tid < 256) { const int cg8 = tid & 15, seg = tid >> 4, t0 = 4 * seg; float o[4][8];
        conv8x4(P, PROJ, cid, PC_B + 128 * g + 8 * cg8, 512 + 128 * g + 8 * cg8, t0, o);
#pragma unroll
        for (int e = 0; e < 8; ++e) { u32x2 w; w.x = pk2(o[0][e], o[1][e]); w.y = pk2(o[2][e], o[3][e]); *(LAS u32x2*)(BmT + (8 * cg8 + e) * XT_STR + t0) = w; } }
    __syncthreads();
    const int hh = wave >> 1, ph = wave & 1, h = 4 * g + hh, fr = lane & 15, fq = lane >> 4;
    f32x4 acc[2][8];
#pragma unroll
    for (int pt = 0; pt < 2; ++pt)
#pragma unroll
        for (int nt = 0; nt < 8; ++nt) acc[pt][nt] = (f32x4){0.f, 0.f, 0.f, 0.f};
#pragma unroll
    for (int ks = 0; ks < 2; ++ks) { bf16x8 a[2];
#pragma unroll
        for (int pt = 0; pt < 2; ++pt) a[pt] = *(const LAS bf16x8*)(xsT + (64 * hh + 32 * ph + 16 * pt + fr) * XT_STR + 32 * ks + 8 * fq);
#pragma unroll
        for (int nt = 0; nt < 8; ++nt) { const bf16x8 b = *(const LAS bf16x8*)(BmT + (16 * nt + fr) * XT_STR + 32 * ks + 8 * fq);
#pragma unroll
            for (int pt = 0; pt < 2; ++pt) acc[pt][nt] = __builtin_amdgcn_mfma_f32_16x16x32_bf16(a[pt], b, acc[pt][nt], 0, 0, 0); } }
    float* bp = BST + ((size_t)cid * 8 + h) * 8192;
#pragma unroll
    for (int pt = 0; pt < 2; ++pt)
#pragma unroll
        for (int nt = 0; nt < 8; ++nt)
#pragma unroll
            for (int i = 0; i < 4; ++i) bp[(32 * ph + 16 * pt + 4 * fq + i) * 128 + 16 * nt + fr] = acc[pt][nt][i];
    __syncthreads();
}

__device__ __forceinline__ void p3_scan(const Params& P, int tid, int G) {
    asm volatile("" : "+v"(tid));
    const float* CDEC = (const float*)(P.ws + WS_CDEC); const float* BST = (const float*)(P.ws + WS_BSTATE); bf16* SPV = (bf16*)(P.ws + WS_SPREV); const bf16* PROJ = (const bf16*)(P.ws + WS_PROJ);
    const int gt = blockIdx.x * NTHREADS + tid, NT = G * NTHREADS;
    for (int item = gt; item < 131072; item += NT) { const int b = item >> 14, e = item & 16383, h = e >> 11; const size_t eo = (size_t)e * 4;
        f32x4 s = (f32x4){0.f, 0.f, 0.f, 0.f};
        for (int c0 = 0; c0 < 64; c0 += 8) { f32x4 bs[8]; float dc[8];
#pragma unroll
            for (int u = 0; u < 8; ++u) { const size_t cid = (size_t)b * 64 + c0 + u; bs[u] = *(const f32x4*)(BST + cid * 65536 + eo); dc[u] = CDEC[cid * 8 + h]; }
#pragma unroll
            for (int u = 0; u < 8; ++u) { const size_t cid = (size_t)b * 64 + c0 + u; u32x2 w; w.x = pk2(s[0], s[1]); w.y = pk2(s[2], s[3]); *(u32x2*)(SPV + cid * 65536 + eo) = w; s = s * dc[u] + bs[u]; } }
        *(f32x4*)(P.out + O_SSMP + (size_t)b * 65536 + eo) = s;
        { const size_t cid = NCH_P + b; const f32x4 s0 = *(const f32x4*)(P.state_ssm + (size_t)b * 65536 + eo); u32x2 w; w.x = pk2(s0[0], s0[1]); w.y = pk2(s0[2], s0[3]); *(u32x2*)(SPV + cid * 65536 + eo) = w;
            *(f32x4*)(P.out + O_SSMS + (size_t)b * 65536 + eo) = s0 * CDEC[cid * 8 + h] + *(const f32x4*)(BST + cid * 65536 + eo); } }
    for (int i = gt; i < 24576; i += NT) { const int b = i / 3072, r = (i / 1024) % 3, ch = i & 1023;
        P.out[O_CONVP + i] = bf2f(PROJ[((size_t)b * SEQ + SEQ - 3 + r) * NPROJ + PC_XS + ch]);
        P.out[O_CONVS + i] = bf2f(PROJ[((size_t)MP + b * 64 + 61 + r) * NPROJ + PC_XS + ch]); }
    for (int i = gt; i < 131072; i += NT) { const int b = i >> 14, j = (i >> 7) & 127, kd = i & 127;
        const size_t rp = ((size_t)b * SEQ + SEQ - 128 + j) * NPROJ;
        P.out[O_KP + i] = bf2f(PROJ[rp + PC_K + kd]); P.out[O_VP + i] = bf2f(PROJ[rp + PC_V + kd]);
        if (j < 64) { const size_t o = ((size_t)b * 128 + j + 64) * 128 + kd; P.out[O_KS + i] = P.cache_k[o]; P.out[O_VS + i] = P.cache_v[o]; }
        else { const size_t rs = ((size_t)MP + b * 64 + j - 64) * NPROJ; P.out[O_KS + i] = bf2f(PROJ[rs + PC_K + kd]); P.out[O_VS + i] = bf2f(PROJ[rs + PC_V + kd]); } }
}

constexpr int YT_STR = 260;
__device__ __forceinline__ void ssd_unit(const Params& P, LAS unsigned char* lds, int cid, int g, int tid, int lane, int wave) {
    asm volatile("" : "+v"(tid), "+v"(lane));
    const bf16* PROJ = (const bf16*)(P.ws + WS_PROJ); const float* DT = (const float*)(P.ws + WS_DT); const bf16* SPV = (const bf16*)(P.ws + WS_SPREV); bf16* MIXED = (bf16*)(P.ws + WS_MIXED);
    LAS bf16* xsT = (LAS bf16*)lds;
    LAS bf16* Bm = (LAS bf16*)(lds + 36864);
    LAS bf16* Cm = (LAS bf16*)(lds + 36864 + 17408);
    LAS float* CB = (LAS float*)(lds + 36864 + 2 * 17408);
    LAS float* dts = (LAS float*)(lds + 36864 + 3 * 17408);
    LAS float* cums = dts + 256;
    LAS float* yt = (LAS float*)lds;
    const size_t m0 = (size_t)cid * 64;
    if (wave < 4) { const int h = 4 * g + wave; const float dt = DT[(m0 + lane) * 8 + h]; const float a = -__expf(P.a_log[h]);
        const float cum = wave_incl_scan(dt * a, lane); dts[wave * 64 + lane] = dt; cums[wave * 64 + lane] = cum; }
    { const int cg8 = tid & 31, seg = tid >> 5, t0 = 4 * seg; float o[4][8];
        conv8x4(P, PROJ, cid, PC_XS + 256 * g + 8 * cg8, 256 * g + 8 * cg8, t0, o);
#pragma unroll
        for (int e = 0; e < 8; ++e) { u32x2 w; w.x = pk2(o[0][e], o[1][e]); w.y = pk2(o[2][e], o[3][e]); *(LAS u32x2*)(xsT + (8 * cg8 + e) * XT_STR + t0) = w; }
        const int isC = cg8 >> 4, c16 = cg8 & 15;
        conv8x4(P, PROJ, cid, (isC ? PC_C : PC_B) + 128 * g + 8 * c16, (isC ? 768 : 512) + 128 * g + 8 * c16, t0, o);
        LAS bf16* dst = isC ? Cm : Bm;
#pragma unroll
        for (int tt = 0; tt < 4; ++tt) { u32x4 w; w.x = pk2(o[tt][0], o[tt][1]); w.y = pk2(o[tt][2], o[tt][3]); w.z = pk2(o[tt][4], o[tt][5]); w.w = pk2(o[tt][6], o[tt][7]); *(LAS u32x4*)(dst + (t0 + tt) * BM_STR + 8 * c16) = w; } }
    __syncthreads();
    const int fr = lane & 15, fq = lane >> 4;
    { const int lt = wave >> 1, st0 = 2 * (wave & 1); f32x4 ca[2] = {(f32x4){0.f, 0.f, 0.f, 0.f}, (f32x4){0.f, 0.f, 0.f, 0.f}};
#pragma unroll
        for (int ks = 0; ks < 4; ++ks) { const bf16x8 a = *(const LAS bf16x8*)(Cm + (16 * lt + fr) * BM_STR + 32 * ks + 8 * fq);
#pragma unroll
            for (int u = 0; u < 2; ++u) { const bf16x8 b = *(const LAS bf16x8*)(Bm + (16 * (st0 + u) + fr) * BM_STR + 32 * ks + 8 * fq); ca[u] = __builtin_amdgcn_mfma_f32_16x16x32_bf16(a, b, ca[u], 0, 0, 0); } }
#pragma unroll
        for (int u = 0; u < 2; ++u)
#pragma unroll
            for (int i = 0; i < 4; ++i) CB[(16 * lt + 4 * fq + i) * CB_STR + 16 * (st0 + u) + fr] = ca[u][i]; }
    __syncthreads();
    const int hh = wave >> 1, ph = wave & 1, h = 4 * g + hh;
    f32x4 acc[4][2];
#pragma unroll
    for (int lt = 0; lt < 4; ++lt)
#pragma unroll
        for (int pt = 0; pt < 2; ++pt) acc[lt][pt] = (f32x4){0.f, 0.f, 0.f, 0.f};
    {
        bf16x8 sb[2][4]; const bf16* sp = SPV + (((size_t)cid * 8 + h) * 64 + 32 * ph + fr) * 128 + 8 * fq;
#pragma unroll
        for (int pt = 0; pt < 2; ++pt)
#pragma unroll
            for (int ks = 0; ks < 4; ++ks) sb[pt][ks] = *(const bf16x8*)(sp + (size_t)pt * 16 * 128 + 32 * ks);
#pragma unroll
        for (int lt = 0; lt < 4; ++lt)
#pragma unroll
            for (int ks = 0; ks < 4; ++ks) { const bf16x8 a = *(const LAS bf16x8*)(Cm + (16 * lt + fr) * BM_STR + 32 * ks + 8 * fq);
#pragma unroll
                for (int pt = 0; pt < 2; ++pt) acc[lt][pt] = __builtin_amdgcn_mfma_f32_16x16x32_bf16(a, sb[pt][ks], acc[lt][pt], 0, 0, 0); }
#pragma unroll
        for (int lt = 0; lt < 4; ++lt) { const f32x4 c4 = *(const LAS f32x4*)(cums + hh * 64 + 16 * lt + 4 * fq);
#pragma unroll
            for (int i = 0; i < 4; ++i) { const float e = __expf(c4[i]); acc[lt][0][i] *= e; acc[lt][1][i] *= e; } }
    }
#pragma unroll
    for (int lt = 0; lt < 4; ++lt)
#pragma unroll
        for (int ks = 0; ks < 2; ++ks) { if (32 * ks > 16 * lt + 15) continue;
            const int l = 16 * lt + fr, s0 = 32 * ks + 8 * fq; const float cl = cums[hh * 64 + l];
            const f32x4 cb0 = *(const LAS f32x4*)(CB + l * CB_STR + s0), cb1 = *(const LAS f32x4*)(CB + l * CB_STR + s0 + 4);
            const f32x4 cs0 = *(const LAS f32x4*)(cums + hh * 64 + s0), cs1 = *(const LAS f32x4*)(cums + hh * 64 + s0 + 4);
            const f32x4 d0 = *(const LAS f32x4*)(dts + hh * 64 + s0), d1 = *(const LAS f32x4*)(dts + hh * 64 + s0 + 4);
            float mv[8];
#pragma unroll
            for (int j = 0; j < 4; ++j) { mv[j] = (s0 + j <= l) ? cb0[j] * __expf(fminf(cl - cs0[j], 0.f)) * d0[j] : 0.f; mv[4 + j] = (s0 + 4 + j <= l) ? cb1[j] * __expf(fminf(cl - cs1[j], 0.f)) * d1[j] : 0.f; }
            union { u32x4 u; bf16x8 v; } af; af.u.x = pk2(mv[0], mv[1]); af.u.y = pk2(mv[2], mv[3]); af.u.z = pk2(mv[4], mv[5]); af.u.w = pk2(mv[6], mv[7]);
#pragma unroll
            for (int pt = 0; pt < 2; ++pt) { const bf16x8 b = *(const LAS bf16x8*)(xsT + (64 * hh + 32 * ph + 16 * pt + fr) * XT_STR + s0); acc[lt][pt] = __builtin_amdgcn_mfma_f32_16x16x32_bf16(af.v, b, acc[lt][pt], 0, 0, 0); } }
    { const float dsk = P.d_skip[h];
#pragma unroll
        for (int lt = 0; lt < 4; ++lt)
#pragma unroll
            for (int pt = 0; pt < 2; ++pt) { const u32x2 xw = *(const LAS u32x2*)(xsT + (64 * hh + 32 * ph + 16 * pt + fr) * XT_STR + 16 * lt + 4 * fq);
                acc[lt][pt][0] += dsk * __uint_as_float(xw.x << 16); acc[lt][pt][1] += dsk * __uint_as_float(xw.x & 0xffff0000u); acc[lt][pt][2] += dsk * __uint_as_float(xw.y << 16); acc[lt][pt][3] += dsk * __uint_as_float(xw.y & 0xffff0000u); } }
    __syncthreads();
#pragma unroll
    for (int lt = 0; lt < 4; ++lt)
#pragma unroll
        for (int pt = 0; pt < 2; ++pt)
#pragma unroll
            for (int i = 0; i < 4; ++i) yt[(16 * lt + 4 * fq + i) * YT_STR + 64 * hh + 32 * ph + 16 * pt + fr] = acc[lt][pt][i];
    __syncthreads();
    const f32x4 nw = *(const f32x4*)(P.ssm_norm_w + 256 * g + 4 * lane);
#pragma unroll
    for (int q = 0; q < 8; ++q) { const int l = 8 * wave + q; const f32x4 y = *(const LAS f32x4*)(yt + l * YT_STR + 4 * lane);
        const u32x2 zw = *(const u32x2*)(PROJ + (m0 + l) * NPROJ + PC_Z + 256 * g + 4 * lane);
        f32x4 gg; gg[0] = y[0] * silu_f(__uint_as_float(zw.x << 16)); gg[1] = y[1] * silu_f(__uint_as_float(zw.x & 0xffff0000u)); gg[2] = y[2] * silu_f(__uint_as_float(zw.y << 16)); gg[3] = y[3] * silu_f(__uint_as_float(zw.y & 0xffff0000u));
        const float ss = wave_sum(gg[0] * gg[0] + gg[1] * gg[1] + gg[2] * gg[2] + gg[3] * gg[3]); const float rs = 1.0f / sqrtf(ss * (1.0f / 256.0f) + RMS_EPS);
        u32x2 w; w.x = pk2(gg[0] * rs * nw[0], gg[1] * rs * nw[1]); w.y = pk2(gg[2] * rs * nw[2], gg[3] * rs * nw[3]);
        *(u32x2*)(MIXED + (m0 + l) * DM + 256 * g + 4 * lane) = w; }
    __syncthreads();
}

__device__ __forceinline__ void ln_rows(const float* in, const float* gam, const float* bet, bf16* obf, float* of32, int lane, int wave, int G) {
    asm volatile("" : "+v"(lane));
    const int gw = blockIdx.x * NWAVES + wave, NGW = G * NWAVES;
    f32x4 gv[4], bv[4];
#pragma unroll
    for (int j = 0; j < 4; ++j) { gv[j] = *(const f32x4*)(gam + 4 * lane + 256 * j); bv[j] = *(const f32x4*)(bet + 4 * lane + 256 * j); }
    for (int m = gw; m < M; m += NGW) { const float* xr = in + (size_t)m * DM + 4 * lane;
        f32x4 v[4]; float s = 0.f;
#pragma unroll
        for (int j = 0; j < 4; ++j) { v[j] = *(const f32x4*)(xr + 256 * j); s += (v[j][0] + v[j][1]) + (v[j][2] + v[j][3]); }
        const float mean = wave_sum(s) * (1.f / DM); float s2 = 0.f;
#pragma unroll
        for (int j = 0; j < 4; ++j) { v[j] = v[j] - mean; s2 += (v[j][0] * v[j][0] + v[j][1] * v[j][1]) + (v[j][2] * v[j][2] + v[j][3] * v[j][3]); }
        const float rstd = 1.f / sqrtf(wave_sum(s2) * (1.f / DM) + LN_EPS);
#pragma unroll
        for (int j = 0; j < 4; ++j) { const f32x4 o = v[j] * rstd * gv[j] + bv[j];
            if (obf) { u32x2 w; w.x = pk2(o[0], o[1]); w.y = pk2(o[2], o[3]); *(u32x2*)(obf + (size_t)m * DM + 4 * lane + 256 * j) = w; }
            if (of32) *(f32x4*)(of32 + (size_t)m * DM + 4 * lane + 256 * j) = o; } }
}

#define RLX_AGENT __ATOMIC_RELAXED, __HIP_MEMORY_SCOPE_AGENT
#define XB_TMO      128
#define XB_XCNT(j)  (256  + 64 * (j))
#define XB_XSUB(j)  (1280 + 64 * (j))
#define XB_XGEN(j)  (2304 + 64 * (j))
#define XB_TOP      3328
#define XB_TOPGEN   3392
#define XCD_BAR_WORDS 3456
#define XB_SPIN_CAP (1u << 18)

__device__ __forceinline__ unsigned xb_ld(unsigned* p)              { return __hip_atomic_load(p, __ATOMIC_RELAXED, __HIP_MEMORY_SCOPE_AGENT); }
__device__ __forceinline__ unsigned xb_add(unsigned* p, unsigned v) { return __hip_atomic_fetch_add(p, v, __ATOMIC_RELAXED, __HIP_MEMORY_SCOPE_AGENT); }
__device__ __forceinline__ unsigned xb_xcc_id() { return (unsigned)__builtin_amdgcn_s_getreg((3 << 11) | 20) & 0xFu; }
#define XB_SPIN(cond, bar) do { unsigned _sp = 0; while (cond) { __builtin_amdgcn_s_sleep(1); \
    if ((++_sp & 255u) == 0u) { if (xb_ld(&(bar)[XB_TMO])) break; if (_sp > XB_SPIN_CAP) { atomicAdd(&(bar)[XB_TMO], 1u); break; } } } } while (0)

struct XcdBarrier {
    unsigned* bar; unsigned x;
    volatile LAS unsigned* st;
};

__device__ __forceinline__ XcdBarrier xcd_barrier_post(unsigned* bar, volatile LAS unsigned* st) {
    XcdBarrier b; b.bar = bar; b.x = xb_xcc_id(); b.st = st;
    if (threadIdx.x == 0) (void)xb_add(&bar[XB_XCNT(b.x)], 1u);
    return b;
}
__device__ __forceinline__ void xcd_barrier_complete(unsigned* bar, unsigned x, unsigned& nloc, unsigned& nx) {
    const unsigned G = gridDim.x * gridDim.y * gridDim.z;
    unsigned sum, cnt, mine, sp = 0u;
    for (;;) {
        sum = 0u; cnt = 0u; mine = 0u;
#pragma unroll
        for (unsigned j = 0; j < 16; ++j) { const unsigned c = xb_ld(&bar[XB_XCNT(j)]); sum += c; cnt += (c > 0u) ? 1u : 0u; mine = (j == x) ? c : mine; }
        if (sum == G) break;
        __builtin_amdgcn_s_sleep(1);
        if ((++sp & 255u) == 0u) { if (xb_ld(&bar[XB_TMO])) break; if (sp > XB_SPIN_CAP) { atomicAdd(&bar[XB_TMO], 1u); break; } }
    }
    nloc = mine > 0u ? mine : 1u; nx = cnt > 0u ? cnt : 1u;
}

__device__ __forceinline__ void xcd_barrier(const XcdBarrier& b) {
    asm volatile("s_waitcnt vmcnt(0)" ::: "memory");
    __syncthreads();
    if (threadIdx.x == 0) {
        unsigned* bar = b.bar;
        __builtin_amdgcn_s_waitcnt(0);
        unsigned nloc = b.st[0], nx = b.st[1];
        if (nloc == 0u) { xcd_barrier_complete(bar, b.x, nloc, nx); b.st[0] = nloc; b.st[1] = nx; }
        const unsigned old = xb_add(&bar[XB_XSUB(b.x)], 1u);
        const unsigned gen = old / nloc;
        if (old + 1u == (gen + 1u) * nloc) {
            __builtin_amdgcn_fence(__ATOMIC_RELEASE, "agent");
            asm volatile("s_waitcnt vmcnt(0)" ::: "memory");
            const unsigned og = xb_add(&bar[XB_TOP], 1u);
            const unsigned tg = og / nx;
            if (og + 1u == (tg + 1u) * nx) xb_add(&bar[XB_TOPGEN], 1u);
            else XB_SPIN(xb_ld(&bar[XB_TOPGEN]) == tg, bar);
            __builtin_amdgcn_fence(__ATOMIC_ACQUIRE, "agent");
            xb_add(&bar[XB_XGEN(b.x)], 1u);
            asm volatile("s_waitcnt vmcnt(0)" ::: "memory");
        } else {
            XB_SPIN(xb_ld(&bar[XB_XGEN(b.x)]) == gen, bar);
            __builtin_amdgcn_fence(__ATOMIC_ACQUIRE, "agent");
            asm volatile("s_waitcnt vmcnt(0)" ::: "memory");
        }
    }
    __syncthreads();
}
#ifndef PHMASK
#define PHMASK 0x3ff
#endif
#define PH(n) ((PHMASK >> (n)) & 1)
#ifndef DBLMASK
#define DBLMASK 0
#endif
#define REP(n) for (int rep_ = 0; rep_ < 1 + ((DBLMASK >> (n)) & 1); ++rep_)
__global__ void __launch_bounds__(NTHREADS, 2) hymba_fwd(Params P) {
    extern __shared__ __attribute__((aligned(16))) unsigned char lds_raw[];
    LAS unsigned char* lds = (LAS unsigned char*)lds_raw;
    cg::grid_group grid = cg::this_grid();
    const int tid = threadIdx.x, lane = tid & 63, wave = __builtin_amdgcn_readfirstlane(tid >> 6), G = gridDim.x;
    unsigned char* ws = P.ws;
    if (G == 0x7fffffff) grid.sync();
    volatile LAS unsigned* bst = (volatile LAS unsigned*)(lds + 131072);
    if (tid < 2) bst[tid] = 0u;
    __syncthreads();
    const XcdBarrier xbar = xcd_barrier_post((unsigned*)ws, bst);
#define GSYNC() xcd_barrier(xbar)
    bf16* WIN = (bf16*)(ws + WS_WIN); bf16* WOUT = (bf16*)(ws + WS_WOUT); bf16* WGU = (bf16*)(ws + WS_WGU); bf16* WDN = (bf16*)(ws + WS_WDN);
    bf16* XB = (bf16*)(ws + WS_XB); bf16* PROJ = (bf16*)(ws + WS_PROJ); bf16* MIXED = (bf16*)(ws + WS_MIXED); bf16* HB = (bf16*)(ws + WS_H); bf16* ACT = (bf16*)(ws + WS_ACT);

#if PH(0)
    REP(0) p0_prologue(P, lds, tid, lane, wave, G);
#endif
    GSYNC();
#if PH(1)
    REP(1) {
        pg8::Gemm g{XB, WIN, M, NPROJ, DM}; pg8::StaticOrder S; S.init(M, NPROJ, G, (int)blockIdx.x);
        pg8::EpiBf16<0> E{PROJ, NPROJ, nullptr, 0, 0, 1.f};
        pg8::gemm_phase<pg8::EpiBf16<0>, pg8::StaticOrder, true, true>(lds, g, S, E);
    }
    GSYNC();
#endif
#if PH(2)
    REP(2) for (int u = blockIdx.x; u < 4 * NCH; u += G) {
#if !defined(NO_ATTN)
        if (u < 2 * NCH) attn_unit(P, lds, u >> 1, u & 1, tid, lane, wave);
#endif
#if !defined(NO_BST)
        if (u >= 2 * NCH) { const int v = u - 2 * NCH; bstate_unit(P, lds, v >> 1, v & 1, tid, lane, wave); }
#endif
    }
    GSYNC();
#endif
#if PH(3)
    REP(3) p3_scan(P, tid, G);
#ifdef XSYNC
    for (int xs_ = 0; xs_ < XSYNC; ++xs_) GSYNC();
#endif
#endif
    GSYNC();
#if PH(4)
    REP(4) for (int u = blockIdx.x; u < 2 * NCH; u += G) ssd_unit(P, lds, u >> 1, u & 1, tid, lane, wave);
    GSYNC();
#endif
#if PH(5)
    REP(5) {
        pg8::Gemm g{MIXED, WOUT, M, DM, DM}; pg8::StaticOrder S; S.init(M, DM, G, (int)blockIdx.x);
        pg8::EpiResF32 E{P.x_prompt, P.x_sample, MP / 256, P.out + O_Y, DM, ALPHA};
        pg8::gemm_phase<pg8::EpiResF32, pg8::StaticOrder, true, true>(lds, g, S, E);
    }
    GSYNC();
#endif
#if PH(6)
    REP(6) ln_rows(P.out + O_Y, P.ln1_g, P.ln1_b, HB, nullptr, lane, wave, G);
    GSYNC();
#endif
#if PH(7)
    REP(7) {
        pg8::Gemm g{HB, WGU, M, NGU, DM}; pg8::StaticOrder S; S.init(M, NGU, G, (int)blockIdx.x);
        pg8::EpiSwiglu E{ACT, DFF};
        pg8::gemm_phase<pg8::EpiSwiglu, pg8::StaticOrder, true, true>(lds, g, S, E);
    }
    GSYNC();
#endif
#if PH(8)
    REP(8) {
        pg8::Gemm g{ACT, WDN, M, DM, DFF}; pg8::StaticOrder S; S.init(M, DM, G, (int)blockIdx.x);
        pg8::EpiResBf16In E{HB, P.out + O_Y, DM, ALPHA};
        pg8::gemm_phase<pg8::EpiResBf16In, pg8::StaticOrder, true, true>(lds, g, S, E);
    }
    GSYNC();
#endif
#if PH(9)
    ln_rows(P.out + O_Y, P.ln2_g, P.ln2_b, nullptr, P.out + O_Y, lane, wave, G);
#endif
}

extern "C" void kernel_launch(void* const* d_in, const int* in_sizes, int n_in, void* d_out, int out_size, void* d_ws, size_t ws_size, hipStream_t stream) {
    static int grid = 0;
    if (grid == 0) {
        if (n_in != 22 || (size_t)out_size != O_END || ws_size < WS_END) { fprintf(stderr, "kernel_launch: unexpected shapes: n_in %d out %d ws %zu (need %zu)\n", n_in, out_size, ws_size, (size_t)WS_END); grid = -1; return; }
        int dev = 0, cus = 0, per_cu = 0;
        hipGetDevice(&dev); hipDeviceGetAttribute(&cus, hipDeviceAttributeMultiprocessorCount, dev);
        hipFuncSetAttribute((const void*)hymba_fwd, hipFuncAttributeMaxDynamicSharedMemorySize, LDS_BYTES);
        hipOccupancyMaxActiveBlocksPerMultiprocessor(&per_cu, (const void*)hymba_fwd, NTHREADS, LDS_BYTES);
        if (per_cu < 1) { fprintf(stderr, "kernel_launch: occupancy query says %d blocks/CU\n", per_cu); per_cu = 1; }
        grid = cus * per_cu;
    }
    if (grid < 0) return;
    Params p{};
    const float** pp = (const float**)&p;
    for (int i = 0; i < 22; ++i) pp[i] = (const float*)d_in[i];
    p.out = (float*)d_out; p.ws = (unsigned char*)d_ws;
    if (hipMemsetAsync(d_ws, 0, 16384, stream) != hipSuccess) { fprintf(stderr, "memset failed\n"); return; }
    void* args[] = {&p};
    hipError_t e = hipLaunchCooperativeKernel((const void*)hymba_fwd, dim3(grid), dim3(NTHREADS), args, LDS_BYTES, stream);
    if (e != hipSuccess) fprintf(stderr, "cooperative launch failed: %s (grid %d)\n", hipGetErrorString(e), grid);
}
```

```cpp
#include <hip/hip_runtime.h>
#include <hip/hip_cooperative_groups.h>
#include <cstdio>
#include <cstdint>
namespace cg = cooperative_groups;
namespace pg8 {
#define PG8_LAS __attribute__((address_space(3)))
typedef unsigned short bf16_t;
typedef short bf16x8 __attribute__((ext_vector_type(8)));
typedef float f32x4 __attribute__((ext_vector_type(4)));
typedef unsigned u32x4 __attribute__((ext_vector_type(4)));
constexpr int BM = 256, BK = 64, HALF = 128, HTB = HALF * BK * 2  , STAGE_BYTES = 8 * HTB, NXCD = 8, WGM = 8;

__host__ __device__ __forceinline__ int lds_byte(int r, int c) { const int st = (r >> 4) * 2 + (c >> 5), rr = r & 15, cc = c & 31, ob = rr * 64 + cc * 2; return st * 1024 + (ob ^ (((ob >> 9) & 1) << 5)); }
__host__ __device__ __forceinline__ void stage_rc(int b, int& R, int& C) { const int st = b / 1024, sb = b % 1024, swz = sb ^ (((sb >> 9) & 1) << 5); R = (st >> 1) * 16 + swz / 64; C = (st & 1) * 32 + (swz % 64) / 2; }
__host__ __device__ __forceinline__ int perm32(int rho) { const int n = rho >> 4, i = rho & 15; return 8 * (i >> 2) + 4 * n + (i & 3); }

struct Unit { int pm, pn, k0; };
struct Gemm { const bf16_t* A; const bf16_t* Bt; int M, N, K, KL; };

struct StaticOrder {
    int nM, nN, nwg, G, c;
    __host__ __device__ void init(int M, int N, int G_, int c_) { nM = M / BM; nN = N / BM; nwg = nM * nN; G = G_; c = c_; }
    __host__ __device__ bool next(int i, Unit& u) const {
        const long L = (long)i * G + c; if (L >= nwg) return false;
        int wgid = (int)L; { const int q = nwg / NXCD, r = nwg % NXCD, xcd = wgid % NXCD, off = wgid / NXCD; wgid = (xcd < r ? xcd * (q + 1) : r * (q + 1) + (xcd - r) * q) + off; }
        const int nig = WGM * nN, gid = wgid / nig, fm = gid * WGM, gsz = (nM - fm) < WGM ? (nM - fm) : WGM;
        u.pm = fm + ((wgid % nig) % gsz); u.pn = (wgid % nig) / gsz; u.k0 = 0; return true;
    }
    __device__ __forceinline__ void a_ready(const Unit&) const {}
    __device__ __forceinline__ void done(const Unit&) const {}
};

struct TailOrder {
    int pm0, nitems, S, KL, G, c;
    __device__ __forceinline__ bool next(int i, Unit& u) const { const int L = i * G + c; if (L >= nitems) return false; const int un = L / S, ks = L - un * S; u.pm = pm0 + (un >> 2); u.pn = un & 3; u.k0 = ks * KL; return true; }
    __device__ __forceinline__ void a_ready(const Unit&) const {}
    __device__ __forceinline__ void done(const Unit&) const {}
};

__device__ __forceinline__ unsigned cvt_pk_bf16(float lo, float hi) { unsigned r; asm volatile("v_cvt_pk_bf16_f32 %0, %1, %2" : "=v"(r) : "v"(lo), "v"(hi)); return r; }
typedef float f32x2 __attribute__((ext_vector_type(2)));
__device__ __forceinline__ f32x2 gelu_pk(f32x2 v) {
    const f32x2 av = __builtin_elementwise_abs(v), d = av * 0.2316418882f + 1.0f;
    f32x2 t; t.x = __builtin_amdgcn_rcpf(d.x); t.y = __builtin_amdgcn_rcpf(d.y);
    f32x2 q = t * 0.5307027145f + (-0.7265760135f); q = q * t + 0.7107068705f; q = q * t + (-0.142248368f); q = q * t + 0.127414796f; q = q * t;
    const f32x2 s = (v * v) * (-0.72134752044f);
    f32x2 e; e.x = __builtin_amdgcn_exp2f(s.x); e.y = __builtin_amdgcn_exp2f(s.y);
    const f32x2 m = v * (q * e), r = v - m;
    f32x2 o; o.x = v.x < 0.f ? m.x : r.x; o.y = v.y < 0.f ? m.y : r.y; return o;
}

template <int ACT  > struct EpiBf16 {
    static constexpr bool PERM = true, AFTER_DRAIN = false; static_assert(ACT == 0 || ACT == 1, "EpiBf16: ACT is 0 (none) or 1 (gelu_pk)");
    bf16_t* O; int ldc; const float* bias; int split_cols; size_t split_stride; float scale0;
    __device__ __forceinline__ void operator()(const f32x4 (&acc)[2][2][4][2], const Unit& u, int wr, int wc, int fr, int fq) const {
        const int row0 = u.pm * BM + wr * 64 + fr; int colt = u.pn * BM; bf16_t* base = O;
        float sc = 1.f; if (split_cols) { const int t = colt / split_cols; base += (size_t)t * split_stride; colt -= t * split_cols; if (t == 0) sc = scale0; }
        const int col0 = colt + wc * 32 + 8 * fq, bcol0 = u.pn * BM + wc * 32 + 8 * fq;
        f32x4 bv[2][2];
#pragma unroll
        for (int bj = 0; bj < 2; ++bj)
#pragma unroll
            for (int n = 0; n < 2; ++n) bv[bj][n] = bias ? *(const f32x4*)(bias + bcol0 + bj * HALF + 4 * n) : (f32x4){0.f, 0.f, 0.f, 0.f};
#pragma unroll
        for (int ai = 0; ai < 2; ++ai)
#pragma unroll
            for (int m = 0; m < 4; ++m) { bf16_t* rowp = base + (size_t)(row0 + ai * HALF + m * 16) * ldc + col0;
#pragma unroll
                for (int bj = 0; bj < 2; ++bj) { f32x4 v0 = acc[ai][bj][m][0] + bv[bj][0], v1 = acc[ai][bj][m][1] + bv[bj][1];
                    if (ACT == 1) { f32x2 a = gelu_pk((f32x2){v0[0], v0[1]}), b = gelu_pk((f32x2){v0[2], v0[3]}), c = gelu_pk((f32x2){v1[0], v1[1]}), d = gelu_pk((f32x2){v1[2], v1[3]});
                        v0 = (f32x4){a.x, a.y, b.x, b.y}; v1 = (f32x4){c.x, c.y, d.x, d.y}; }
                    v0 = v0 * sc; v1 = v1 * sc; u32x4 w; w.x = cvt_pk_bf16(v0[0], v0[1]); w.y = cvt_pk_bf16(v0[2], v0[3]); w.z = cvt_pk_bf16(v1[0], v1[1]); w.w = cvt_pk_bf16(v1[2], v1[3]);
                    *(u32x4*)(rowp + bj * HALF) = w; } }
    }
};
template <class Epi, class Sched, bool ALIGN_EPI = false, bool SP2 = false>
__device__ __forceinline__ void gemm_phase(PG8_LAS unsigned char* lds, const Gemm g, const Sched& S, const Epi& E) {
    int tid_o = threadIdx.x; asm volatile("" : "+v"(tid_o));
    const int tid = tid_o, wid = __builtin_amdgcn_readfirstlane(tid >> 6), lane = tid & 63, wr = wid >> 2, wc = wid & 3, fr = lane & 15, fq = lane >> 4;
    const int K = g.K, nt = g.KL / BK;
    unsigned voffA[2], voffB[2];
#pragma unroll
    for (int i = 0; i < 2; ++i) { int R, C; stage_rc(tid * 16 + i * 8192, R, C); const int Rb = Epi::PERM ? ((R & ~31) + perm32(R & 31)) : R;
        voffA[i] = (unsigned)(R * K + C) * 2u; voffB[i] = (unsigned)(Rb * K + C) * 2u; }
    const size_t kstep = (size_t)(BK * 2);
    const size_t hstep = (size_t)HALF * K * 2;
    const size_t tstep = 2 * hstep;
    const unsigned ldsw = (unsigned)wid * 1024u;
    const int aoff = lds_byte(wr * 64 + fr, fq * 8), boff = lds_byte(wc * 32 + fr, fq * 8);
#define PG8_SA(b, h) (((b) * 2 + (h)) * HTB)
#define PG8_SB(b, h) ((4 + (b) * 2 + (h)) * HTB)
#define PG8_STAGE(bufoff, gbase, voff) do { _Pragma("unroll") for (int _i = 0; _i < 2; ++_i) \
        __builtin_amdgcn_global_load_lds((const unsigned*)((const char*)(gbase) + (voff)[_i]), (PG8_LAS unsigned*)(lds + (bufoff) + ldsw + _i * 8192), 16, 0, 0); } while (0)
#define PG8_LDA(dst, b, h) do { _Pragma("unroll") for (int m = 0; m < 4; ++m) _Pragma("unroll") for (int k = 0; k < 2; ++k) dst[m][k] = *(const PG8_LAS bf16x8*)(lds + PG8_SA(b, h) + aoff + m * 2048 + k * 1024); } while (0)
#define PG8_LDB(dst, b, h) do { _Pragma("unroll") for (int n = 0; n < 2; ++n) _Pragma("unroll") for (int k = 0; k < 2; ++k) dst[n][k] = *(const PG8_LAS bf16x8*)(lds + PG8_SB(b, h) + boff + n * 2048 + k * 1024); } while (0)
#define PG8_MMA(ai, bj, At, Bt) do { __builtin_amdgcn_s_setprio(1); _Pragma("unroll") for (int m = 0; m < 4; ++m) _Pragma("unroll") for (int n = 0; n < 2; ++n) _Pragma("unroll") for (int k = 0; k < 2; ++k) \
        acc[ai][bj][m][n] = __builtin_amdgcn_mfma_f32_16x16x32_bf16(Bt[n][k], At[m][k], acc[ai][bj][m][n], 0, 0, 0); __builtin_amdgcn_s_setprio(0); } while (0)
#define PG8_WAIT_V(n) asm volatile("s_waitcnt vmcnt(" #n ")" ::: "memory")
#define PG8_WAIT_L(n) asm volatile("s_waitcnt lgkmcnt(" #n ")" ::: "memory")
#define PG8_BAR __builtin_amdgcn_s_barrier()
#define PG8_SCHED __builtin_amdgcn_sched_barrier(0)
    Unit cur, nxt; int ui = 0;
    if (!S.next(0, cur)) return;
    f32x4 acc[2][2][4][2];
#pragma unroll
    for (int a = 0; a < 2; ++a)
#pragma unroll
        for (int b = 0; b < 2; ++b)
#pragma unroll
            for (int m = 0; m < 4; ++m)
#pragma unroll
                for (int n = 0; n < 2; ++n) acc[a][b][m][n] = (f32x4){0.f, 0.f, 0.f, 0.f};
    bf16x8 At[4][2], B0[2][2], B1[2][2];
    const char* cA = (const char*)g.A + (size_t)cur.pm * tstep + (size_t)cur.k0 * 2; const char* cB = (const char*)g.Bt + (size_t)cur.pn * tstep + (size_t)cur.k0 * 2;
    S.a_ready(cur);
    if constexpr (SP2) {
        PG8_STAGE(PG8_SB(0, 0), cB, voffB); PG8_STAGE(PG8_SB(0, 1), cB + hstep, voffB); PG8_STAGE(PG8_SA(0, 0), cA, voffA); PG8_STAGE(PG8_SA(0, 1), cA + hstep, voffA);
        if (wr == 1) PG8_BAR;
        PG8_WAIT_V(2); PG8_BAR;
        PG8_STAGE(PG8_SB(1, 0), cB + kstep, voffB); PG8_STAGE(PG8_SA(1, 0), cA + kstep, voffA); PG8_STAGE(PG8_SB(1, 1), cB + hstep + kstep, voffB);
        PG8_WAIT_V(6); PG8_BAR;
    } else {
        PG8_STAGE(PG8_SB(0, 0), cB, voffB); PG8_STAGE(PG8_SA(0, 0), cA, voffA); PG8_STAGE(PG8_SB(0, 1), cB + hstep, voffB); PG8_STAGE(PG8_SA(0, 1), cA + hstep, voffA);
        if (wr == 1) PG8_BAR;
        PG8_WAIT_V(4); PG8_BAR;
        PG8_STAGE(PG8_SB(1, 0), cB + kstep, voffB); PG8_STAGE(PG8_SA(1, 0), cA + kstep, voffA); PG8_STAGE(PG8_SB(1, 1), cB + hstep + kstep, voffB);
        PG8_WAIT_V(6); PG8_BAR;
    }
    for (;;) {
        const bool has_next = S.next(ui + 1, nxt);
        const char* nA = has_next ? (const char*)g.A + (size_t)nxt.pm * tstep + (size_t)nxt.k0 * 2 : cA; const char* nB = has_next ? (const char*)g.Bt + (size_t)nxt.pn * tstep + (size_t)nxt.k0 * 2 : cB;
        for (int t = 0; t < nt; t += 2) {
            const bool last = (t == nt - 2);
            const char* a1 = cA + (size_t)(t + 1) * kstep;
            const char* a2 = last ? nA : cA + (size_t)(t + 2) * kstep; const char* b2 = last ? nB : cB + (size_t)(t + 2) * kstep;
            const char* a3 = a2 + kstep; const char* b3 = b2 + kstep;
            if (last && has_next) S.a_ready(nxt);
            if constexpr (SP2) {
            PG8_LDB(B0, 0, 0); PG8_LDB(B1, 0, 1); PG8_SCHED; PG8_LDA(At, 0, 0); PG8_STAGE(PG8_SA(1, 1), a1 + hstep, voffA);
            PG8_WAIT_V(8); PG8_WAIT_L(0); PG8_BAR; PG8_MMA(0, 0, At, B0); PG8_MMA(0, 1, At, B1); PG8_BAR; PG8_SCHED;
            PG8_LDA(At, 0, 1); PG8_STAGE(PG8_SB(0, 0), b2, voffB); PG8_STAGE(PG8_SB(0, 1), b2 + hstep, voffB); PG8_STAGE(PG8_SA(0, 0), a2, voffA);
            PG8_WAIT_V(8); PG8_WAIT_L(0); PG8_BAR; PG8_MMA(1, 0, At, B0); PG8_MMA(1, 1, At, B1); PG8_BAR; PG8_SCHED;
            PG8_LDB(B0, 1, 0); PG8_LDB(B1, 1, 1); PG8_SCHED; PG8_LDA(At, 1, 0); PG8_STAGE(PG8_SA(0, 1), a2 + hstep, voffA);
            PG8_WAIT_V(8); PG8_WAIT_L(0); PG8_BAR; PG8_MMA(0, 0, At, B0); PG8_MMA(0, 1, At, B1); PG8_BAR; PG8_SCHED;
            PG8_LDA(At, 1, 1); PG8_STAGE(PG8_SB(1, 0), b3, voffB); PG8_STAGE(PG8_SB(1, 1), b3 + hstep, voffB); PG8_STAGE(PG8_SA(1, 0), a3, voffA);
            PG8_WAIT_V(8); PG8_WAIT_L(0); PG8_BAR; PG8_MMA(1, 0, At, B0); PG8_MMA(1, 1, At, B1); PG8_BAR; PG8_SCHED;
            } else {
            PG8_LDB(B0, 0, 0); PG8_SCHED; PG8_LDA(At, 0, 0); PG8_STAGE(PG8_SA(1, 1), a1 + hstep, voffA);
            PG8_WAIT_L(8); PG8_BAR; PG8_WAIT_L(0); PG8_MMA(0, 0, At, B0); PG8_BAR; PG8_SCHED;
            PG8_LDB(B1, 0, 1); PG8_STAGE(PG8_SB(0, 0), b2, voffB);
            PG8_BAR; PG8_WAIT_L(0); PG8_MMA(0, 1, At, B1); PG8_BAR;
            PG8_LDA(At, 0, 1); PG8_STAGE(PG8_SA(0, 0), a2, voffA);
            PG8_BAR; PG8_WAIT_L(0); PG8_MMA(1, 0, At, B0); PG8_BAR; PG8_SCHED;
            PG8_STAGE(PG8_SB(0, 1), b2 + hstep, voffB);
            PG8_WAIT_V(6); PG8_BAR; PG8_MMA(1, 1, At, B1); PG8_BAR;
            PG8_LDB(B0, 1, 0); PG8_SCHED; PG8_LDA(At, 1, 0); PG8_STAGE(PG8_SA(0, 1), a2 + hstep, voffA);
            PG8_WAIT_L(8); PG8_BAR; PG8_WAIT_L(0); PG8_MMA(0, 0, At, B0); PG8_BAR; PG8_SCHED;
            PG8_LDB(B1, 1, 1); PG8_STAGE(PG8_SB(1, 0), b3, voffB);
            PG8_BAR; PG8_WAIT_L(0); PG8_MMA(0, 1, At, B1); PG8_BAR;
            PG8_LDA(At, 1, 1); PG8_STAGE(PG8_SA(1, 0), a3, voffA);
            PG8_BAR; PG8_WAIT_L(0); PG8_MMA(1, 0, At, B0); PG8_BAR; PG8_SCHED;
            PG8_STAGE(PG8_SB(1, 1), b3 + hstep, voffB);
            PG8_WAIT_V(6); PG8_BAR; PG8_MMA(1, 1, At, B1); PG8_BAR;
            }
        }
        if constexpr (ALIGN_EPI) { if (wr == 0) PG8_BAR; }
        if constexpr (!Epi::AFTER_DRAIN) { E(acc, cur, wr, wc, fr, fq); S.done(cur); }
        if (!has_next) break;
#pragma unroll
        for (int a = 0; a < 2; ++a)
#pragma unroll
            for (int b = 0; b < 2; ++b)
#pragma unroll
                for (int m = 0; m < 4; ++m)
#pragma unroll
                    for (int n = 0; n < 2; ++n) acc[a][b][m][n] = (f32x4){0.f, 0.f, 0.f, 0.f};
        cur = nxt; cA = nA; cB = nB; ++ui;
        if constexpr (ALIGN_EPI) { if (wr == 1) PG8_BAR; }
    }
    PG8_WAIT_V(0);
    if constexpr (!ALIGN_EPI) { if (wr == 0) PG8_BAR; }
    PG8_BAR;
    if constexpr (Epi::AFTER_DRAIN) { E.fused(acc, cur, wr, wc, fr, fq, lds, wid, lane); S.done(cur); }
#undef PG8_SA
#undef PG8_SB
#undef PG8_STAGE
#undef PG8_LDA
#undef PG8_LDB
#undef PG8_MMA
#undef PG8_WAIT_V
#undef PG8_WAIT_L
#undef PG8_BAR
#undef PG8_SCHED
}
}
namespace pg8 {
struct EpiResF32 {
    static constexpr bool PERM = false, AFTER_DRAIN = false;
    const float* xp; const float* xs; int split_pm; float* out; int ldc; float alpha;
    __device__ __forceinline__ void operator()(const f32x4 (&acc)[2][2][4][2], const Unit& u, int wr, int wc, int fr, int fq) const {
        const int col0 = u.pn * BM + wc * 32 + 4 * fq;
        const float* bp = (u.pm < split_pm) ? xp + (size_t)u.pm * BM * ldc : xs + (size_t)(u.pm - split_pm) * BM * ldc;
        float* op = out + (size_t)u.pm * BM * ldc;
#pragma unroll
        for (int ai = 0; ai < 2; ++ai)
#pragma unroll
            for (int m = 0; m < 4; ++m) { const size_t off = (size_t)(ai * HALF + wr * 64 + m * 16 + fr) * ldc + col0;
#pragma unroll
                for (int bj = 0; bj < 2; ++bj)
#pragma unroll
                    for (int n = 0; n < 2; ++n) { const f32x4 bs = *(const f32x4*)(bp + off + bj * HALF + n * 16); const f32x4 o = bs * alpha + acc[ai][bj][m][n]; *(f32x4*)(op + off + bj * HALF + n * 16) = o; }
                if (m & 1) asm volatile("" ::: "memory"); }
    }
};
struct EpiResBf16In {
    static constexpr bool PERM = false, AFTER_DRAIN = false;
    const bf16_t* h; float* out; int ldc; float alpha;
    __device__ __forceinline__ void operator()(const f32x4 (&acc)[2][2][4][2], const Unit& u, int wr, int wc, int fr, int fq) const {
        typedef unsigned u32x2v __attribute__((ext_vector_type(2)));
        const int col0 = u.pn * BM + wc * 32 + 4 * fq;
#pragma unroll
        for (int ai = 0; ai < 2; ++ai)
#pragma unroll
            for (int m = 0; m < 4; ++m) { const size_t off = (size_t)(u.pm * BM + ai * HALF + wr * 64 + m * 16 + fr) * ldc + col0;
#pragma unroll
                for (int bj = 0; bj < 2; ++bj)
#pragma unroll
                    for (int n = 0; n < 2; ++n) { const u32x2v hb = *(const u32x2v*)(h + off + bj * HALF + n * 16);
                        f32x4 bs; bs[0] = __uint_as_float(hb.x << 16); bs[1] = __uint_as_float(hb.x & 0xffff0000u); bs[2] = __uint_as_float(hb.y << 16); bs[3] = __uint_as_float(hb.y & 0xffff0000u);
                        const f32x4 o = bs * alpha + acc[ai][bj][m][n]; *(f32x4*)(out + off + bj * HALF + n * 16) = o; }
                if (m & 1) asm volatile("" ::: "memory"); }
    }
};
struct EpiPartF32 {
    static constexpr bool PERM = false, AFTER_DRAIN = false;
    float* part; int ldc, row0, rows, KL;
    __device__ __forceinline__ void operator()(const f32x4 (&acc)[2][2][4][2], const Unit& u, int wr, int wc, int fr, int fq) const {
        const int col0 = u.pn * BM + wc * 32 + 4 * fq; float* pb = part + (size_t)(u.k0 / KL) * rows * ldc;
#pragma unroll
        for (int ai = 0; ai < 2; ++ai)
#pragma unroll
            for (int m = 0; m < 4; ++m) { float* op = pb + (size_t)(u.pm * BM - row0 + ai * HALF + wr * 64 + m * 16 + fr) * ldc + col0;
#pragma unroll
                for (int bj = 0; bj < 2; ++bj)
#pragma unroll
                    for (int n = 0; n < 2; ++n) *(f32x4*)(op + bj * HALF + n * 16) = acc[ai][bj][m][n]; }
    }
};
struct EpiSwiglu {
    static constexpr bool PERM = true, AFTER_DRAIN = false;
    bf16_t* O; int ldc;
    __device__ __forceinline__ void operator()(const f32x4 (&acc)[2][2][4][2], const Unit& u, int wr, int wc, int fr, int fq) const {
        const int row0 = u.pm * BM + wr * 64 + fr; const int col0 = u.pn * HALF + wc * 32 + 8 * fq;
#pragma unroll
        for (int ai = 0; ai < 2; ++ai)
#pragma unroll
            for (int m = 0; m < 4; ++m) { bf16_t* rowp = O + (size_t)(row0 + ai * HALF + m * 16) * ldc + col0;
                float v[8];
#pragma unroll
                for (int n = 0; n < 2; ++n)
#pragma unroll
                    for (int e = 0; e < 4; ++e) { const float g = acc[ai][0][m][n][e], up = acc[ai][1][m][n][e]; v[n * 4 + e] = g * __builtin_amdgcn_rcpf(1.0f + __expf(-g)) * up; }
                u32x4 w; w.x = cvt_pk_bf16(v[0], v[1]); w.y = cvt_pk_bf16(v[2], v[3]); w.z = cvt_pk_bf16(v[4], v[5]); w.w = cvt_pk_bf16(v[6], v[7]);
                *(u32x4*)rowp = w; }
    }
};
}
#define LAS __attribute__((address_space(3)))
typedef unsigned short bf16;
typedef short bf16x8 __attribute__((ext_vector_type(8)));
typedef short s16x4 __attribute__((ext_vector_type(4)));
typedef float f32x4 __attribute__((ext_vector_type(4)));
typedef float f32x16 __attribute__((ext_vector_type(16)));
typedef unsigned u32x4 __attribute__((ext_vector_type(4)));
typedef unsigned u32x2 __attribute__((ext_vector_type(2)));

constexpr int NWAVES = 8, NTHREADS = 512;
constexpr int DM = 1024, BATCH = 8, SEQ = 4096, DEC_T = 64;
constexpr int MP = BATCH * SEQ, MS = BATCH * DEC_T, M = MP + MS;
constexpr int NCH_P = MP / 64, NCH = M / 64;
constexpr int IN_COLS = 2312, NPROJ = 2304, DFF = 2816, NGU = 2 * DFF;
constexpr int PC_Z = 0, PC_XS = 512, PC_B = 1024, PC_C = 1280, PC_Q = 1536, PC_K = 2048, PC_V = 2176;
constexpr float LN_EPS = 1e-5f, RMS_EPS = 1e-5f, ALPHA = 1.189207115002721f;
constexpr size_t MiB = 1u << 20;
constexpr size_t WS_WIN = 2 * MiB, WS_WOUT = 7 * MiB, WS_WGU = 9 * MiB, WS_WDN = 20 * MiB, WS_DT = 26 * MiB, WS_CDEC = 28 * MiB;
constexpr size_t WS_XB = 32 * MiB, WS_MIXED = WS_XB, WS_PROJ = 97 * MiB, WS_BSTATE = 244 * MiB, WS_SPREV = 374 * MiB, WS_H = 97 * MiB, WS_ACT = 162 * MiB, WS_PART = 376 * MiB, WS_END = 439 * MiB;
static_assert(WS_XB + (size_t)M * DM * 2 <= WS_PROJ && WS_PROJ + (size_t)M * NPROJ * 2 <= WS_BSTATE && WS_BSTATE + (size_t)NCH * 65536 * 4 <= WS_SPREV && WS_SPREV + (size_t)NCH * 65536 * 2 <= WS_END, "ws map");
static_assert(WS_H + (size_t)M * DM * 2 <= WS_ACT && WS_ACT + (size_t)M * DFF * 2 <= WS_END, "ws map 2");
constexpr size_t O_Y = 0, O_CONVP = (size_t)M * DM, O_SSMP = O_CONVP + 24576, O_KP = O_SSMP + 524288, O_VP = O_KP + 131072, O_CONVS = O_VP + 131072, O_SSMS = O_CONVS + 24576, O_KS = O_SSMS + 524288, O_VS = O_KS + 131072, O_END = O_VS + 131072;
constexpr int LDS_BYTES = 147456;

struct Params {
    const float *x_prompt, *x_sample, *state_conv, *state_ssm, *cache_k, *cache_v, *w_in, *conv_w, *conv_b, *dt_bias, *a_log, *d_skip, *ssm_norm_w, *attn_sinks,
                *w_out, *ln1_g, *ln1_b, *w_gate, *w_up, *w_down, *ln2_g, *ln2_b;
    float* out; unsigned char* ws;
};

__device__ __forceinline__ float bf2f(unsigned short h) { return __uint_as_float((unsigned)h << 16); }
__device__ __forceinline__ unsigned pk2(float lo, float hi) { return pg8::cvt_pk_bf16(lo, hi); }
__device__ __forceinline__ float wave_sum(float v) {
#pragma unroll
    for (int o = 1; o < 64; o <<= 1) v += __shfl_xor(v, o);
    return v;
}
__device__ __forceinline__ float silu_f(float v) { return v * __builtin_amdgcn_rcpf(1.0f + __expf(-v)); }
__device__ __forceinline__ void unpack8(const u32x4 w, float (&f)[8]) {
    f[0] = __uint_as_float(w.x << 16); f[1] = __uint_as_float(w.x & 0xffff0000u); f[2] = __uint_as_float(w.y << 16); f[3] = __uint_as_float(w.y & 0xffff0000u);
    f[4] = __uint_as_float(w.z << 16); f[5] = __uint_as_float(w.z & 0xffff0000u); f[6] = __uint_as_float(w.w << 16); f[7] = __uint_as_float(w.w & 0xffff0000u);
}

__device__ __forceinline__ void p0_item(const float* W, int ldw, int k0, int nsrc0, bf16* WT, int K, int drow0, LAS float* scr, int lane) {
#pragma unroll 8
    for (int i = 0; i < 32; ++i) { const int kk = 2 * i + (lane >> 5); scr[kk * 33 + (lane & 31)] = W[(size_t)(k0 + kk) * ldw + nsrc0 + (lane & 31)]; }
    asm volatile("s_waitcnt lgkmcnt(0)" ::: "memory");
    const int c = lane & 7;
#pragma unroll
    for (int j = 0; j < 4; ++j) { const int n = (lane >> 3) + 8 * j; const LAS float* s = scr + (8 * c) * 33 + n;
        u32x4 o; o.x = pk2(s[0 * 33], s[1 * 33]); o.y = pk2(s[2 * 33], s[3 * 33]); o.z = pk2(s[4 * 33], s[5 * 33]); o.w = pk2(s[6 * 33], s[7 * 33]);
        *(u32x4*)(WT + (size_t)(drow0 + n) * K + k0 + 8 * c) = o; }
    asm volatile("s_waitcnt lgkmcnt(0)" ::: "memory");
}

__device__ __forceinline__ void p0_prologue(const Params& P, LAS unsigned char* lds, int tid, int lane, int wave, int G) {
    unsigned char* ws = P.ws;
    bf16* WIN = (bf16*)(ws + WS_WIN); bf16* WOUT = (bf16*)(ws + WS_WOUT); bf16* WGU = (bf16*)(ws + WS_WGU); bf16* WDN = (bf16*)(ws + WS_WDN);
    bf16* XB = (bf16*)(ws + WS_XB); float* DT = (float*)(ws + WS_DT);
    LAS float* scr = (LAS float*)(lds + wave * 8448);
    LAS float* wdt = (LAS float*)(lds + 73728);
    for (int i = tid; i < 8192; i += NTHREADS) { const int k = i >> 3, h = i & 7; wdt[h * 1024 + k] = P.w_in[(size_t)k * IN_COLS + 1536 + h]; }
    const int gw = blockIdx.x * NWAVES + wave, NGW = G * NWAVES;
    constexpr int I_IN = 16 * 72, I_OUT = 16 * 32, I_GU = 16 * 176, I_DN = 44 * 32, NITEMS = I_IN + I_OUT + I_GU + I_DN;
    for (int it = gw; it < NITEMS; it += NGW) {
        int r = it;
        if (r < I_IN) { const int kb = r / 72, nb = r % 72, n0 = 32 * nb; p0_item(P.w_in, IN_COLS, 64 * kb, n0 + (n0 >= 1536 ? 8 : 0), WIN, DM, n0, scr, lane); continue; } r -= I_IN;
        if (r < I_OUT) { const int kb = r / 32, nb = r % 32; p0_item(P.w_out, DM, 64 * kb, 32 * nb, WOUT, DM, 32 * nb, scr, lane); continue; } r -= I_OUT;
        if (r < I_GU) { const int kb = r / 176, nb = r % 176, t = nb >> 3, s = (nb >> 2) & 1, i0 = 32 * (nb & 3); p0_item(s ? P.w_up : P.w_gate, DFF, 64 * kb, 128 * t + i0, WGU, DM, 32 * nb, scr, lane); continue; } r -= I_GU;
        { const int kb = r / 32, nb = r % 32; p0_item(P.w_down, DM, 64 * kb, 32 * nb, WDN, DFF, 32 * nb, scr, lane); }
    }
    __syncthreads();
    float bias = 0.f; if (lane < 8) bias = P.dt_bias[lane];
    for (int m = gw; m < M; m += NGW) {
        const float* xrow = (m < MP) ? P.x_prompt + (size_t)m * DM : P.x_sample + (size_t)(m - MP) * DM;
        f32x4 v[4];
#pragma unroll
        for (int j = 0; j < 4; ++j) v[j] = *(const f32x4*)(xrow + 4 * lane + 256 * j);
        unsigned long long* o8 = (unsigned long long*)(XB + (size_t)m * DM) + lane;
#pragma unroll
        for (int j = 0; j < 4; ++j) o8[64 * j] = (unsigned long long)pk2(v[j][0], v[j][1]) | ((unsigned long long)pk2(v[j][2], v[j][3]) << 32);
        float mine = 0.f;
#pragma unroll
        for (int h = 0; h < 8; ++h) { float a = 0.f;
#pragma unroll
            for (int j = 0; j < 4; ++j) { const f32x4 w = *(const LAS f32x4*)(wdt + h * 1024 + 4 * lane + 256 * j); a += v[j][0] * w[0] + v[j][1] * w[1] + v[j][2] * w[2] + v[j][3] * w[3]; }
            a = wave_sum(a); if (lane == h) mine = a; }
        if (lane < 8) { const float xx = mine + bias; DT[(size_t)m * 8 + lane] = (xx > 20.f) ? xx : log1pf(__expf(xx)); }
    }
}

__device__ __forceinline__ void conv8x4(const Params& P, const bf16* PROJ, int cid, int pcol, int cch, int t0, float (&o)[4][8]) {
    const bool sample = cid >= NCH_P; const bool has_prev = (!sample) && ((cid & 63) != 0);
    const size_t m0 = (size_t)cid * 64;
    float xin[7][8];
#pragma unroll
    for (int rr = 0; rr < 7; ++rr) { const int lt = t0 - 3 + rr;
        if (lt >= 0 || has_prev) { const u32x4 w = *(const u32x4*)(PROJ + (size_t)((long)m0 + lt) * NPROJ + pcol); unpack8(w, xin[rr]); }
        else if (sample) { const float* sc = P.state_conv + ((size_t)(cid - NCH_P) * 3 + (lt + 3)) * 1024 + cch; const f32x4 a = *(const f32x4*)sc, b = *(const f32x4*)(sc + 4);
            xin[rr][0] = a[0]; xin[rr][1] = a[1]; xin[rr][2] = a[2]; xin[rr][3] = a[3]; xin[rr][4] = b[0]; xin[rr][5] = b[1]; xin[rr][6] = b[2]; xin[rr][7] = b[3]; }
        else {
#pragma unroll
            for (int e = 0; e < 8; ++e) xin[rr][e] = 0.f; } }
    float cw[4][8], cb[8];
#pragma unroll
    for (int i = 0; i < 4; ++i) { const f32x4 a = *(const f32x4*)(P.conv_w + i * 1024 + cch), b = *(const f32x4*)(P.conv_w + i * 1024 + cch + 4);
        cw[i][0] = a[0]; cw[i][1] = a[1]; cw[i][2] = a[2]; cw[i][3] = a[3]; cw[i][4] = b[0]; cw[i][5] = b[1]; cw[i][6] = b[2]; cw[i][7] = b[3]; }
    { const f32x4 a = *(const f32x4*)(P.conv_b + cch), b = *(const f32x4*)(P.conv_b + cch + 4); cb[0] = a[0]; cb[1] = a[1]; cb[2] = a[2]; cb[3] = a[3]; cb[4] = b[0]; cb[5] = b[1]; cb[6] = b[2]; cb[7] = b[3]; }
#pragma unroll
    for (int tt = 0; tt < 4; ++tt)
#pragma unroll
        for (int e = 0; e < 8; ++e) { float a = cb[e];
#pragma unroll
            for (int i = 0; i < 4; ++i) a += cw[i][e] * xin[tt + i][e];
            o[tt][e] = silu_f(a); }
}

constexpr int KS_STR = 72, VT_STR = 200;
__device__ __forceinline__ void attn_unit(const Params& P, LAS unsigned char* lds, int cid, int kv, int tid, int lane, int wave) {
    asm volatile("" : "+v"(tid), "+v"(lane));
    const bf16* PROJ = (const bf16*)(P.ws + WS_PROJ); bf16* MIXED = (bf16*)(P.ws + WS_MIXED);
    LAS bf16* Ks = (LAS bf16*)lds; LAS bf16* VT = (LAS bf16*)(lds + 192 * KS_STR * 2);
    const bool sample = cid >= NCH_P; const int c = cid & 63; const size_t m0 = (size_t)cid * 64;
    for (int idx = tid; idx < 1536; idx += NTHREADS) { const int j = idx >> 3, ch = idx & 7;
        u32x4 k8 = (u32x4){0u, 0u, 0u, 0u}, v8 = (u32x4){0u, 0u, 0u, 0u};
        if (sample && j < 128) { const size_t o = (((size_t)(cid - NCH_P) * 128 + j) * 2 + kv) * 64 + ch * 8;
            const f32x4 a = *(const f32x4*)(P.cache_k + o), b = *(const f32x4*)(P.cache_k + o + 4), cc = *(const f32x4*)(P.cache_v + o), d = *(const f32x4*)(P.cache_v + o + 4);
            k8.x = pk2(a[0], a[1]); k8.y = pk2(a[2], a[3]); k8.z = pk2(b[0], b[1]); k8.w = pk2(b[2], b[3]);
            v8.x = pk2(cc[0], cc[1]); v8.y = pk2(cc[2], cc[3]); v8.z = pk2(d[0], d[1]); v8.w = pk2(d[2], d[3]); }
        else if (sample || (c * 64 - 128 + j >= 0)) { const bf16* rp = PROJ + (size_t)((long)m0 - 128 + j) * NPROJ + kv * 64 + ch * 8; k8 = *(const u32x4*)(rp + PC_K); v8 = *(const u32x4*)(rp + PC_V); }
        *(LAS u32x4*)(Ks + j * KS_STR + ch * 8) = k8;
        LAS bf16* vp = VT + (ch * 8) * VT_STR + j;
        vp[0 * VT_STR] = (bf16)(v8.x & 0xffff); vp[1 * VT_STR] = (bf16)(v8.x >> 16); vp[2 * VT_STR] = (bf16)(v8.y & 0xffff); vp[3 * VT_STR] = (bf16)(v8.y >> 16);
        vp[4 * VT_STR] = (bf16)(v8.z & 0xffff); vp[5 * VT_STR] = (bf16)(v8.z >> 16); vp[6 * VT_STR] = (bf16)(v8.w & 0xffff); vp[7 * VT_STR] = (bf16)(v8.w >> 16); }
    __syncthreads();
    const int r = wave >> 1, th = wave & 1, hq = kv * 4 + r, l31 = lane & 31, hh = lane >> 5; int tq = 32 * th + l31; asm volatile("" : "+v"(tq));
    const bf16* qp = PROJ + (m0 + tq) * NPROJ + PC_Q + hq * 64 + 8 * hh;
    bf16x8 qf[4];
#pragma unroll
    for (int ks = 0; ks < 4; ++ks) qf[ks] = *(const bf16x8*)(qp + 16 * ks);
    f32x16 sacc[6];
#pragma unroll
    for (int kt = 0; kt < 6; ++kt) {
#pragma unroll
        for (int i = 0; i < 16; ++i) sacc[kt][i] = 0.f;
#pragma unroll
        for (int ks = 0; ks < 4; ++ks) { const bf16x8 a = *(const LAS bf16x8*)(Ks + (32 * kt + l31) * KS_STR + 16 * ks + 8 * hh); sacc[kt] = __builtin_amdgcn_mfma_f32_32x32x16_bf16(a, qf[ks], sacc[kt], 0, 0, 0); }
        __builtin_amdgcn_sched_barrier(0); }
    const float slope = exp2f(-(float)(hq + 1)), sink = P.attn_sinks[hq];
    float mx = sink;
#pragma unroll
    for (int kt = 0; kt < 6; ++kt) { const bool valid = sample || (2 * c + kt >= 4);
#pragma unroll
        for (int i = 0; i < 16; ++i) { const int key = 32 * kt + (i & 3) + 8 * (i >> 2) + 4 * hh; const float dist = fabsf((float)(128 + tq - key));
            const float s = valid ? (sacc[kt][i] * 0.125f - slope * dist) : -INFINITY; sacc[kt][i] = s; mx = fmaxf(mx, s); }
        __builtin_amdgcn_sched_barrier(0); }
    mx = fmaxf(mx, __shfl_xor(mx, 32));
    float sum = 0.f;
#pragma unroll
    for (int kt = 0; kt < 6; ++kt)
#pragma unroll
        for (int i = 0; i < 16; ++i) { const float p = __expf(sacc[kt][i] - mx); sacc[kt][i] = p; sum += p; }
    sum += __shfl_xor(sum, 32);
    const float inv = 1.0f / (sum + __expf(sink - mx));
    f32x16 oacc[2];
#pragma unroll
    for (int d2 = 0; d2 < 2; ++d2)
#pragma unroll
        for (int i = 0; i < 16; ++i) oacc[d2][i] = 0.f;
#pragma unroll
    for (int kt = 0; kt < 6; ++kt)
#pragma unroll
        for (int s2 = 0; s2 < 2; ++s2) {
            union { u32x4 u; bf16x8 v; } pf;
            pf.u.x = pk2(sacc[kt][8 * s2 + 0], sacc[kt][8 * s2 + 1]); pf.u.y = pk2(sacc[kt][8 * s2 + 2], sacc[kt][8 * s2 + 3]);
            pf.u.z = pk2(sacc[kt][8 * s2 + 4], sacc[kt][8 * s2 + 5]); pf.u.w = pk2(sacc[kt][8 * s2 + 6], sacc[kt][8 * s2 + 7]);
#pragma unroll
            for (int d2 = 0; d2 < 2; ++d2) { const LAS bf16* vp = VT + (32 * d2 + l31) * VT_STR + 32 * kt + 16 * s2 + 4 * hh;
                union { u32x4 u; bf16x8 v; } af; const u32x2 lo = *(const LAS u32x2*)vp, hi = *(const LAS u32x2*)(vp + 8); af.u.x = lo.x; af.u.y = lo.y; af.u.z = hi.x; af.u.w = hi.y;
                oacc[d2] = __builtin_amdgcn_mfma_f32_32x32x16_bf16(af.v, pf.v, oacc[d2], 0, 0, 0); }
            __builtin_amdgcn_sched_barrier(0); }
    bf16* op = MIXED + (m0 + tq) * DM + 512 + hq * 64 + 4 * hh;
#pragma unroll
    for (int d2 = 0; d2 < 2; ++d2)
#pragma unroll
        for (int rg = 0; rg < 4; ++rg) { u32x2 w; w.x = pk2(oacc[d2][4 * rg] * inv, oacc[d2][4 * rg + 1] * inv); w.y = pk2(oacc[d2][4 * rg + 2] * inv, oacc[d2][4 * rg + 3] * inv);
            *(u32x2*)(op + 32 * d2 + 8 * rg) = w; }
    __syncthreads();
}

constexpr int XT_STR = 72, BM_STR = 136, CB_STR = 68;
__device__ __forceinline__ float wave_incl_scan(float v, int lane) {
#pragma unroll
    for (int o = 1; o < 64; o <<= 1) { const float t = __shfl_up(v, o); if (lane >= o) v += t; }
    return v;
}
__device__ __forceinline__ void bstate_unit(const Params& P, LAS unsigned char* lds, int cid, int g, int tid, int lane, int wave) {
    asm volatile("" : "+v"(tid), "+v"(lane));
    const bf16* PROJ = (const bf16*)(P.ws + WS_PROJ); const float* DT = (const float*)(P.ws + WS_DT); float* CDEC = (float*)(P.ws + WS_CDEC); float* BST = (float*)(P.ws + WS_BSTATE);
    LAS bf16* xsT = (LAS bf16*)lds;
    LAS bf16* BmT = (LAS bf16*)(lds + 256 * XT_STR * 2);
    LAS float* wsc = (LAS float*)(lds + 256 * XT_STR * 2 + 128 * XT_STR * 2);
    const size_t m0 = (size_t)cid * 64;
    if (wave < 4) { const int h = 4 * g + wave; const float dt = DT[(m0 + lane) * 8 + h]; const float a = -__expf(P.a_log[h]);
        const float cum = wave_incl_scan(dt * a, lane); const float tot = __shfl(cum, 63);
        wsc[wave * 64 + lane] = dt * __expf(tot - cum); if (lane == 63) CDEC[cid * 8 + h] = __expf(tot); }
    __syncthreads();
    { const int cg8 = tid & 31, seg = tid >> 5, t0 = 4 * seg; float o[4][8];
        conv8x4(P, PROJ, cid, PC_XS + 256 * g + 8 * cg8, 256 * g + 8 * cg8, t0, o);
        const int hh = cg8 >> 3; const f32x4 w4 = *(const LAS f32x4*)(wsc + hh * 64 + t0);
#pragma unroll
        for (int e = 0; e < 8; ++e) { u32x2 w; w.x = pk2(o[0][e] * w4[0], o[1][e] * w4[1]); w.y = pk2(o[2][e] * w4[2], o[3][e] * w4[3]); *(LAS u32x2*)(xsT + (8 * cg8 + e) * XT_STR + t0) = w; } }
    if (tid < 256) { const int cg8 = tid & 15, seg = tid >> 4, t0 = 4 * seg; float o[4][8];
        conv8x4(P, PROJ, cid, PC_B + 128 * g + 8 * cg8, 512 + 128 * g + 8 * cg8, t0, o);
#pragma unroll
        for (int e = 0; e < 8; ++e) { u32x2 w; w.x = pk2(o[0][e], o[1][e]); w.y = pk2(o[2][e], o[3][e]); *(LAS u32x2*)(BmT + (8 * cg8 + e) * XT_STR + t0) = w; } }
    __syncthreads();
    const int hh = wave >> 1, ph = wave & 1, h = 4 * g + hh, fr = lane & 15, fq = lane >> 4;
    f32x4 acc[2][8];
#pragma unroll
    for (int pt = 0; pt < 2; ++pt)
#pragma unroll
        for (int nt = 0; nt < 8; ++nt) acc[pt][nt] = (f32x4){0.f, 0.f, 0.f, 0.f};
#pragma unroll
    for (int ks = 0; ks < 2; ++ks) { bf16x8 a[2];
#pragma unroll
        for (int pt = 0; pt < 2; ++pt) a[pt] = *(const LAS bf16x8*)(xsT + (64 * hh + 32 * ph + 16 * pt + fr) * XT_STR + 32 * ks + 8 * fq);
#pragma unroll
        for (int nt = 0; nt < 8; ++nt) { const bf16x8 b = *(const LAS bf16x8*)(BmT + (16 * nt + fr) * XT_STR + 32 * ks + 8 * fq);
#pragma unroll
            for (int pt = 0; pt < 2; ++pt) acc[pt][nt] = __builtin_amdgcn_mfma_f32_16x16x32_bf16(a[pt], b, acc[pt][nt], 0, 0, 0); } }
    float* bp = BST + ((size_t)cid * 8 + h) * 8192;
#pragma unroll
    for (int pt = 0; pt < 2; ++pt)
#pragma unroll
        for (int nt = 0; nt < 8; ++nt)
#pragma unroll
            for (int i = 0; i < 4; ++i) bp[(32 * ph + 16 * pt + 4 * fq + i) * 128 + 16 * nt + fr] = acc[pt][nt][i];
    __syncthreads();
}

__device__ __forceinline__ void p3_scan(const Params& P, int tid, int G) {
    asm volatile("" : "+v"(tid));
    const float* CDEC = (const float*)(P.ws + WS_CDEC); const float* BST = (const float*)(P.ws + WS_BSTATE); bf16* SPV = (bf16*)(P.ws + WS_SPREV); const bf16* PROJ = (const bf16*)(P.ws + WS_PROJ);
    const int gt = blockIdx.x * NTHREADS + tid, NT = G * NTHREADS;
    for (int item = gt; item < 131072; item += NT) { const int b = item >> 14, e = item & 16383, h = e >> 11; const size_t eo = (size_t)e * 4;
        f32x4 s = (f32x4){0.f, 0.f, 0.f, 0.f};
        for (int c0 = 0; c0 < 64; c0 += 8) { f32x4 bs[8]; float dc[8];
#pragma unroll
            for (int u = 0; u < 8; ++u) { const size_t cid = (size_t)b * 64 + c0 + u; bs[u] = *(const f32x4*)(BST + cid * 65536 + eo); dc[u] = CDEC[cid * 8 + h]; }
#pragma unroll
            for (int u = 0; u < 8; ++u) { const size_t cid = (size_t)b * 64 + c0 + u; u32x2 w; w.x = pk2(s[0], s[1]); w.y = pk2(s[2], s[3]); *(u32x2*)(SPV + cid * 65536 + eo) = w; s = s * dc[u] + bs[u]; } }
        *(f32x4*)(P.out + O_SSMP + (size_t)b * 65536 + eo) = s;
        { const size_t cid = NCH_P + b; const f32x4 s0 = *(const f32x4*)(P.state_ssm + (size_t)b * 65536 + eo); u32x2 w; w.x = pk2(s0[0], s0[1]); w.y = pk2(s0[2], s0[3]); *(u32x2*)(SPV + cid * 65536 + eo) = w;
            *(f32x4*)(P.out + O_SSMS + (size_t)b * 65536 + eo) = s0 * CDEC[cid * 8 + h] + *(const f32x4*)(BST + cid * 65536 + eo); } }
    for (int i = gt; i < 24576; i += NT) { const int b = i / 3072, r = (i / 1024) % 3, ch = i & 1023;
        P.out[O_CONVP + i] = bf2f(PROJ[((size_t)b * SEQ + SEQ - 3 + r) * NPROJ + PC_XS + ch]);
        P.out[O_CONVS + i] = bf2f(PROJ[((size_t)MP + b * 64 + 61 + r) * NPROJ + PC_XS + ch]); }
    for (int i = gt; i < 131072; i += NT) { const int b = i >> 14, j = (i >> 7) & 127, kd = i & 127;
        const size_t rp = ((size_t)b * SEQ + SEQ - 128 + j) * NPROJ;
        P.out[O_KP + i] = bf2f(PROJ[rp + PC_K + kd]); P.out[O_VP + i] = bf2f(PROJ[rp + PC_V + kd]);
        if (j < 64) { const size_t o = ((size_t)b * 128 + j + 64) * 128 + kd; P.out[O_KS + i] = P.cache_k[o]; P.out[O_VS + i] = P.cache_v[o]; }
        else { const size_t rs = ((size_t)MP + b * 64 + j - 64) * NPROJ; P.out[O_KS + i] = bf2f(PROJ[rs + PC_K + kd]); P.out[O_VS + i] = bf2f(PROJ[rs + PC_V + kd]); } }
}

constexpr int YT_STR = 260;
__device__ __forceinline__ void ssd_unit(const Params& P, LAS unsigned char* lds, int cid, int g, int tid, int lane, int wave) {
    asm volatile("" : "+v"(tid), "+v"(lane));
    const bf16* PROJ = (const bf16*)(P.ws + WS_PROJ); const float* DT = (const float*)(P.ws + WS_DT); const bf16* SPV = (const bf16*)(P.ws + WS_SPREV); bf16* MIXED = (bf16*)(P.ws + WS_MIXED);
    LAS bf16* xsT = (LAS bf16*)lds;
    LAS bf16* Bm = (LAS bf16*)(lds + 36864);
    LAS bf16* Cm = (LAS bf16*)(lds + 36864 + 17408);
    LAS float* CB = (LAS float*)(lds + 36864 + 2 * 17408);
    LAS float* dts = (LAS float*)(lds + 36864 + 3 * 17408);
    LAS float* cums = dts + 256;
    LAS float* yt = (LAS float*)lds;
    const size_t m0 = (size_t)cid * 64;
    if (wave < 4) { const int h = 4 * g + wave; const float dt = DT[(m0 + lane) * 8 + h]; const float a = -__expf(P.a_log[h]);
        const float cum = wave_incl_scan(dt * a, lane); dts[wave * 64 + lane] = dt; cums[wave * 64 + lane] = cum; }
    { const int cg8 = tid & 31, seg = tid >> 5, t0 = 4 * seg; float o[4][8];
        conv8x4(P, PROJ, cid, PC_XS + 256 * g + 8 * cg8, 256 * g + 8 * cg8, t0, o);
#pragma unroll
        for (int e = 0; e < 8; ++e) { u32x2 w; w.x = pk2(o[0][e], o[1][e]); w.y = pk2(o[2][e], o[3][e]); *(LAS u32x2*)(xsT + (8 * cg8 + e) * XT_STR + t0) = w; }
        const int isC = cg8 >> 4, c16 = cg8 & 15;
        conv8x4(P, PROJ, cid, (isC ? PC_C : PC_B) + 128 * g + 8 * c16, (isC ? 768 : 512) + 128 * g + 8 * c16, t0, o);
        LAS bf16* dst = isC ? Cm : Bm;
#pragma unroll
        for (int tt = 0; tt < 4; ++tt) { u32x4 w; w.x = pk2(o[tt][0], o[tt][1]); w.y = pk2(o[tt][2], o[tt][3]); w.z = pk2(o[tt][4], o[tt][5]); w.w = pk2(o[tt][6], o[tt][7]); *(LAS u32x4*)(dst + (t0 + tt) * BM_STR + 8 * c16) = w; } }
    __syncthreads();
    const int fr = lane & 15, fq = lane >> 4;
    { const int lt = wave >> 1, st0 = 2 * (wave & 1); f32x4 ca[2] = {(f32x4){0.f, 0.f, 0.f, 0.f}, (f32x4){0.f, 0.f, 0.f, 0.f}};
#pragma unroll
        for (int ks = 0; ks < 4; ++ks) { const bf16x8 a = *(const LAS bf16x8*)(Cm + (16 * lt + fr) * BM_STR + 32 * ks + 8 * fq);
#pragma unroll
            for (int u = 0; u < 2; ++u) { const bf16x8 b = *(const LAS bf16x8*)(Bm + (16 * (st0 + u) + fr) * BM_STR + 32 * ks + 8 * fq); ca[u] = __builtin_amdgcn_mfma_f32_16x16x32_bf16(a, b, ca[u], 0, 0, 0); } }
#pragma unroll
        for (int u = 0; u < 2; ++u)
#pragma unroll
            for (int i = 0; i < 4; ++i) CB[(16 * lt + 4 * fq + i) * CB_STR + 16 * (st0 + u) + fr] = ca[u][i]; }
    __syncthreads();
    const int hh = wave >> 1, ph = wave & 1, h = 4 * g + hh;
    f32x4 acc[4][2];
#pragma unroll
    for (int lt = 0; lt < 4; ++lt)
#pragma unroll
        for (int pt = 0; pt < 2; ++pt) acc[lt][pt] = (f32x4){0.f, 0.f, 0.f, 0.f};
    {
        bf16x8 sb[2][4]; const bf16* sp = SPV + (((size_t)cid * 8 + h) * 64 + 32 * ph + fr) * 128 + 8 * fq;
#pragma unroll
        for (int pt = 0; pt < 2; ++pt)
#pragma unroll
            for (int ks = 0; ks < 4; ++ks) sb[pt][ks] = *(const bf16x8*)(sp + (size_t)pt * 16 * 128 + 32 * ks);
#pragma unroll
        for (int lt = 0; lt < 4; ++lt)
#pragma unroll
            for (int ks = 0; ks < 4; ++ks) { const bf16x8 a = *(const LAS bf16x8*)(Cm + (16 * lt + fr) * BM_STR + 32 * ks + 8 * fq);
#pragma unroll
                for (int pt = 0; pt < 2; ++pt) acc[lt][pt] = __builtin_amdgcn_mfma_f32_16x16x32_bf16(a, sb[pt][ks], acc[lt][pt], 0, 0, 0); }
#pragma unroll
        for (int lt = 0; lt < 4; ++lt) { const f32x4 c4 = *(const LAS f32x4*)(cums + hh * 64 + 16 * lt + 4 * fq);
#pragma unroll
            for (int i = 0; i < 4; ++i) { const float e = __expf(c4[i]); acc[lt][0][i] *= e; acc[lt][1][i] *= e; } }
    }
#pragma unroll
    for (int lt = 0; lt < 4; ++lt)
#pragma unroll
        for (int ks = 0; ks < 2; ++ks) { if (32 * ks > 16 * lt + 15) continue;
            const int l = 16 * lt + fr, s0 = 32 * ks + 8 * fq; const float cl = cums[hh * 64 + l];
            const f32x4 cb0 = *(const LAS f32x4*)(CB + l * CB_STR + s0), cb1 = *(const LAS f32x4*)(CB + l * CB_STR + s0 + 4);
            const f32x4 cs0 = *(const LAS f32x4*)(cums + hh * 64 + s0), cs1 = *(const LAS f32x4*)(cums + hh * 64 + s0 + 4);
            const f32x4 d0 = *(const LAS f32x4*)(dts + hh * 64 + s0), d1 = *(const LAS f32x4*)(dts + hh * 64 + s0 + 4);
            float mv[8];
#pragma unroll
            for (int j = 0; j < 4; ++j) { mv[j] = (s0 + j <= l) ? cb0[j] * __expf(fminf(cl - cs0[j], 0.f)) * d0[j] : 0.f; mv[4 + j] = (s0 + 4 + j <= l) ? cb1[j] * __expf(fminf(cl - cs1[j], 0.f)) * d1[j] : 0.f; }
            union { u32x4 u; bf16x8 v; } af; af.u.x = pk2(mv[0], mv[1]); af.u.y = pk2(mv[2], mv[3]); af.u.z = pk2(mv[4], mv[5]); af.u.w = pk2(mv[6], mv[7]);
#pragma unroll
            for (int pt = 0; pt < 2; ++pt) { const bf16x8 b = *(const LAS bf16x8*)(xsT + (64 * hh + 32 * ph + 16 * pt + fr) * XT_STR + s0); acc[lt][pt] = __builtin_amdgcn_mfma_f32_16x16x32_bf16(af.v, b, acc[lt][pt], 0, 0, 0); } }
    { const float dsk = P.d_skip[h];
#pragma unroll
        for (int lt = 0; lt < 4; ++lt)
#pragma unroll
            for (int pt = 0; pt < 2; ++pt) { const u32x2 xw = *(const LAS u32x2*)(xsT + (64 * hh + 32 * ph + 16 * pt + fr) * XT_STR + 16 * lt + 4 * fq);
                acc[lt][pt][0] += dsk * __uint_as_float(xw.x << 16); acc[lt][pt][1] += dsk * __uint_as_float(xw.x & 0xffff0000u); acc[lt][pt][2] += dsk * __uint_as_float(xw.y << 16); acc[lt][pt][3] += dsk * __uint_as_float(xw.y & 0xffff0000u); } }
    __syncthreads();
#pragma unroll
    for (int lt = 0; lt < 4; ++lt)
#pragma unroll
        for (int pt = 0; pt < 2; ++pt)
#pragma unroll
            for (int i = 0; i < 4; ++i) yt[(16 * lt + 4 * fq + i) * YT_STR + 64 * hh + 32 * ph + 16 * pt + fr] = acc[lt][pt][i];
    __syncthreads();
    const f32x4 nw = *(const f32x4*)(P.ssm_norm_w + 256 * g + 4 * lane);
#pragma unroll
    for (int q = 0; q < 8; ++q) { const int l = 8 * wave + q; const f32x4 y = *(const LAS f32x4*)(yt + l * YT_STR + 4 * lane);
        const u32x2 zw = *(const u32x2*)(PROJ + (m0 + l) * NPROJ + PC_Z + 256 * g + 4 * lane);
        f32x4 gg; gg[0] = y[0] * silu_f(__uint_as_float(zw.x << 16)); gg[1] = y[1] * silu_f(__uint_as_float(zw.x & 0xffff0000u)); gg[2] = y[2] * silu_f(__uint_as_float(zw.y << 16)); gg[3] = y[3] * silu_f(__uint_as_float(zw.y & 0xffff0000u));
        const float ss = wave_sum(gg[0] * gg[0] + gg[1] * gg[1] + gg[2] * gg[2] + gg[3] * gg[3]); const float rs = 1.0f / sqrtf(ss * (1.0f / 256.0f) + RMS_EPS);
        u32x2 w; w.x = pk2(gg[0] * rs * nw[0], gg[1] * rs * nw[1]); w.y = pk2(gg[2] * rs * nw[2], gg[3] * rs * nw[3]);
        *(u32x2*)(MIXED + (m0 + l) * DM + 256 * g + 4 * lane) = w; }
    __syncthreads();
}

__device__ __forceinline__ void ln_rows(const float* in, const float* gam, const float* bet, bf16* obf, float* of32, const float* part, int nparts, const float* xs, const bf16* hb, int lane, int wave, int G) {
    asm volatile("" : "+v"(lane));
    const int gw = blockIdx.x * NWAVES + wave, NGW = G * NWAVES;
    f32x4 gv[4], bv[4];
#pragma unroll
    for (int j = 0; j < 4; ++j) { gv[j] = *(const f32x4*)(gam + 4 * lane + 256 * j); bv[j] = *(const f32x4*)(bet + 4 * lane + 256 * j); }
    for (int m = gw; m < M; m += NGW) {
        f32x4 v[4]; float s = 0.f;
        if (m < MP) { const float* xr = in + (size_t)m * DM + 4 * lane;
#pragma unroll
            for (int j = 0; j < 4; ++j) v[j] = *(const f32x4*)(xr + 256 * j); }
        else { const size_t ro = (size_t)(m - MP) * DM + 4 * lane;
#pragma unroll
            for (int j = 0; j < 4; ++j) { if (xs) v[j] = *(const f32x4*)(xs + ro + 256 * j) * ALPHA;
                else { const u32x2 hw = *(const u32x2*)(hb + (size_t)m * DM + 4 * lane + 256 * j); v[j][0] = ALPHA * __uint_as_float(hw.x << 16); v[j][1] = ALPHA * __uint_as_float(hw.x & 0xffff0000u); v[j][2] = ALPHA * __uint_as_float(hw.y << 16); v[j][3] = ALPHA * __uint_as_float(hw.y & 0xffff0000u); } }
            for (int sp = 0; sp < nparts; ++sp) { const float* pr = part + (size_t)sp * MS * DM + ro;
#pragma unroll
                for (int j = 0; j < 4; ++j) v[j] = v[j] + *(const f32x4*)(pr + 256 * j); } }
#pragma unroll
        for (int j = 0; j < 4; ++j) s += (v[j][0] + v[j][1]) + (v[j][2] + v[j][3]);
        const float mean = wave_sum(s) * (1.f / DM); float s2 = 0.f;
#pragma unroll
        for (int j = 0; j < 4; ++j) { v[j] = v[j] - mean; s2 += (v[j][0] * v[j][0] + v[j][1] * v[j][1]) + (v[j][2] * v[j][2] + v[j][3] * v[j][3]); }
        const float rstd = 1.f / sqrtf(wave_sum(s2) * (1.f / DM) + LN_EPS);
#pragma unroll
        for (int j = 0; j < 4; ++j) { const f32x4 o = v[j] * rstd * gv[j] + bv[j];
            if (obf) { u32x2 w; w.x = pk2(o[0], o[1]); w.y = pk2(o[2], o[3]); *(u32x2*)(obf + (size_t)m * DM + 4 * lane + 256 * j) = w; }
            if (of32) *(f32x4*)(of32 + (size_t)m * DM + 4 * lane + 256 * j) = o; } }
}

#define RLX_AGENT __ATOMIC_RELAXED, __HIP_MEMORY_SCOPE_AGENT
#define XB_TMO      128
#define XB_XCNT(j)  (256  + 64 * (j))
#define XB_XSUB(j)  (1280 + 64 * (j))
#define XB_XGEN(j)  (2304 + 64 * (j))
#define XB_TOP      3328
#define XB_TOPGEN   3392
#define XCD_BAR_WORDS 3456
#define XB_SPIN_CAP (1u << 18)

__device__ __forceinline__ unsigned xb_ld(unsigned* p)              { return __hip_atomic_load(p, __ATOMIC_RELAXED, __HIP_MEMORY_SCOPE_AGENT); }
__device__ __forceinline__ unsigned xb_add(unsigned* p, unsigned v) { return __hip_atomic_fetch_add(p, v, __ATOMIC_RELAXED, __HIP_MEMORY_SCOPE_AGENT); }
__device__ __forceinline__ unsigned xb_xcc_id() { return (unsigned)__builtin_amdgcn_s_getreg((3 << 11) | 20) & 0xFu; }
#define XB_SPIN(cond, bar) do { unsigned _sp = 0; while (cond) { __builtin_amdgcn_s_sleep(1); \
    if ((++_sp & 255u) == 0u) { if (xb_ld(&(bar)[XB_TMO])) break; if (_sp > XB_SPIN_CAP) { atomicAdd(&(bar)[XB_TMO], 1u); break; } } } } while (0)

struct XcdBarrier {
    unsigned* bar; unsigned x;
    volatile LAS unsigned* st;
};

__device__ __forceinline__ XcdBarrier xcd_barrier_post(unsigned* bar, volatile LAS unsigned* st) {
    XcdBarrier b; b.bar = bar; b.x = xb_xcc_id(); b.st = st;
    if (threadIdx.x == 0) (void)xb_add(&bar[XB_XCNT(b.x)], 1u);
    return b;
}
__device__ __forceinline__ void xcd_barrier_complete(unsigned* bar, unsigned x, unsigned& nloc, unsigned& nx) {
    const unsigned G = gridDim.x * gridDim.y * gridDim.z;
    unsigned sum, cnt, mine, sp = 0u;
    for (;;) {
        sum = 0u; cnt = 0u; mine = 0u;
#pragma unroll
        for (unsigned j = 0; j < 16; ++j) { const unsigned c = xb_ld(&bar[XB_XCNT(j)]); sum += c; cnt += (c > 0u) ? 1u : 0u; mine = (j == x) ? c : mine; }
        if (sum == G) break;
        __builtin_amdgcn_s_sleep(1);
        if ((++sp & 255u) == 0u) { if (xb_ld(&bar[XB_TMO])) break; if (sp > XB_SPIN_CAP) { atomicAdd(&bar[XB_TMO], 1u); break; } }
    }
    nloc = mine > 0u ? mine : 1u; nx = cnt > 0u ? cnt : 1u;
}

__device__ __forceinline__ void xcd_barrier(const XcdBarrier& b) {
    asm volatile("s_waitcnt vmcnt(0)" ::: "memory");
    __syncthreads();
    if (threadIdx.x == 0) {
        unsigned* bar = b.bar;
        __builtin_amdgcn_s_waitcnt(0);
        unsigned nloc = b.st[0], nx = b.st[1];
        if (nloc == 0u) { xcd_barrier_complete(bar, b.x, nloc, nx); b.st[0] = nloc; b.st[1] = nx; }
        const unsigned old = xb_add(&bar[XB_XSUB(b.x)], 1u);
        const unsigned gen = old / nloc;
        if (old + 1u == (gen + 1u) * nloc) {
            __builtin_amdgcn_fence(__ATOMIC_RELEASE, "agent");
            asm volatile("s_waitcnt vmcnt(0)" ::: "memory");
            const unsigned og = xb_add(&bar[XB_TOP], 1u);
            const unsigned tg = og / nx;
            if (og + 1u == (tg + 1u) * nx) xb_add(&bar[XB_TOPGEN], 1u);
            else XB_SPIN(xb_ld(&bar[XB_TOPGEN]) == tg, bar);
            __builtin_amdgcn_fence(__ATOMIC_ACQUIRE, "agent");
            xb_add(&bar[XB_XGEN(b.x)], 1u);
            asm volatile("s_waitcnt vmcnt(0)" ::: "memory");
        } else {
            XB_SPIN(xb_ld(&bar[XB_XGEN(b.x)]) == gen, bar);
            __builtin_amdgcn_fence(__ATOMIC_ACQUIRE, "agent");
            asm volatile("s_waitcnt vmcnt(0)" ::: "memory");
        }
    }
    __syncthreads();
}
#ifndef PHMASK
#define PHMASK 0x3ff
#endif
#define PH(n) ((PHMASK >> (n)) & 1)
#ifndef DBLMASK
#define DBLMASK 0
#endif
#define REP(n) for (int rep_ = 0; rep_ < 1 + ((DBLMASK >> (n)) & 1); ++rep_)
__global__ void __launch_bounds__(NTHREADS, 2) hymba_fwd(Params P) {
    extern __shared__ __attribute__((aligned(16))) unsigned char lds_raw[];
    LAS unsigned char* lds = (LAS unsigned char*)lds_raw;
    cg::grid_group grid = cg::this_grid();
    const int tid = threadIdx.x, lane = tid & 63, wave = __builtin_amdgcn_readfirstlane(tid >> 6), G = gridDim.x;
    unsigned char* ws = P.ws;
    if (G == 0x7fffffff) grid.sync();
    volatile LAS unsigned* bst = (volatile LAS unsigned*)(lds + 131072);
    if (tid < 2) bst[tid] = 0u;
    __syncthreads();
    const XcdBarrier xbar = xcd_barrier_post((unsigned*)ws, bst);
#define GSYNC() xcd_barrier(xbar)
    bf16* WIN = (bf16*)(ws + WS_WIN); bf16* WOUT = (bf16*)(ws + WS_WOUT); bf16* WGU = (bf16*)(ws + WS_WGU); bf16* WDN = (bf16*)(ws + WS_WDN);
    bf16* XB = (bf16*)(ws + WS_XB); bf16* PROJ = (bf16*)(ws + WS_PROJ); bf16* MIXED = (bf16*)(ws + WS_MIXED); bf16* HB = (bf16*)(ws + WS_H); bf16* ACT = (bf16*)(ws + WS_ACT);

#if PH(0)
    REP(0) p0_prologue(P, lds, tid, lane, wave, G);
#endif
    GSYNC();
#if PH(1)
    REP(1) {
        pg8::Gemm g{XB, WIN, M, NPROJ, DM, DM}; pg8::StaticOrder S; S.init(M, NPROJ, G, (int)blockIdx.x);
        pg8::EpiBf16<0> E{PROJ, NPROJ, nullptr, 0, 0, 1.f};
        pg8::gemm_phase<pg8::EpiBf16<0>, pg8::StaticOrder, true, true>(lds, g, S, E);
    }
    GSYNC();
#endif
#if PH(2)
    REP(2) for (int u = blockIdx.x; u < 4 * NCH; u += G) {
#if !defined(NO_ATTN)
        if (u < 2 * NCH) attn_unit(P, lds, u >> 1, u & 1, tid, lane, wave);
#endif
#if !defined(NO_BST)
        if (u >= 2 * NCH) { const int v = u - 2 * NCH; bstate_unit(P, lds, v >> 1, v & 1, tid, lane, wave); }
#endif
    }
    GSYNC();
#endif
#if PH(3)
    REP(3) p3_scan(P, tid, G);
#ifdef XSYNC
    for (int xs_ = 0; xs_ < XSYNC; ++xs_) GSYNC();
#endif
#endif
    GSYNC();
#if PH(4)
    REP(4) for (int u = blockIdx.x; u < 2 * NCH; u += G) ssd_unit(P, lds, u >> 1, u & 1, tid, lane, wave);
    GSYNC();
#endif
#if PH(5)
    REP(5) {
        pg8::Gemm g{MIXED, WOUT, M, DM, DM, DM}; pg8::StaticOrder S; S.init(MP, DM, G, (int)blockIdx.x);
        pg8::EpiResF32 E{P.x_prompt, P.x_sample, MP / 256, P.out + O_Y, DM, ALPHA};
        pg8::gemm_phase<pg8::EpiResF32, pg8::StaticOrder, true, true>(lds, g, S, E);
        pg8::Gemm gt{MIXED, WOUT, M, DM, DM, 256}; pg8::TailOrder T{MP / 256, 32, 4, 256, G, (int)((blockIdx.x + 128) % G)};
        pg8::EpiPartF32 Et{(float*)(ws + WS_PART), DM, MP, MS, 256};
        pg8::gemm_phase<pg8::EpiPartF32, pg8::TailOrder, false, true>(lds, gt, T, Et);
    }
    GSYNC();
#endif
#if PH(6)
    REP(6) ln_rows(P.out + O_Y, P.ln1_g, P.ln1_b, HB, nullptr, (const float*)(ws + WS_PART), 4, P.x_sample, nullptr, lane, wave, G);
    GSYNC();
#endif
#if PH(7)
    REP(7) {
        pg8::Gemm g{HB, WGU, M, NGU, DM, DM}; pg8::StaticOrder S; S.init(M, NGU, G, (int)blockIdx.x);
        pg8::EpiSwiglu E{ACT, DFF};
        pg8::gemm_phase<pg8::EpiSwiglu, pg8::StaticOrder, true, true>(lds, g, S, E);
    }
    GSYNC();
#endif
#if PH(8)
    REP(8) {
        pg8::Gemm g{ACT, WDN, M, DM, DFF, DFF}; pg8::StaticOrder S; S.init(MP, DM, G, (int)blockIdx.x);
        pg8::EpiResBf16In E{HB, P.out + O_Y, DM, ALPHA};
        pg8::gemm_phase<pg8::EpiResBf16In, pg8::StaticOrder, true, true>(lds, g, S, E);
        pg8::Gemm gt{ACT, WDN, M, DM, DFF, 256}; pg8::TailOrder T{MP / 256, 88, 11, 256, G, (int)((blockIdx.x + 128) % G)};
        pg8::EpiPartF32 Et{(float*)(ws + WS_PART), DM, MP, MS, 256};
        pg8::gemm_phase<pg8::EpiPartF32, pg8::TailOrder, false, true>(lds, gt, T, Et);
    }
    GSYNC();
#endif
#if PH(9)
    ln_rows(P.out + O_Y, P.ln2_g, P.ln2_b, nullptr, P.out + O_Y, (const float*)(ws + WS_PART), 11, nullptr, HB, lane, wave, G);
#endif
}

extern "C" void kernel_launch(void* const* d_in, const int* in_sizes, int n_in, void* d_out, int out_size, void* d_ws, size_t ws_size, hipStream_t stream) {
    static int grid = 0;
    if (grid == 0) {
        if (n_in != 22 || (size_t)out_size != O_END || ws_size < WS_END) { fprintf(stderr, "kernel_launch: unexpected shapes: n_in %d out %d ws %zu (need %zu)\n", n_in, out_size, ws_size, (size_t)WS_END); grid = -1; return; }
        int dev = 0, cus = 0, per_cu = 0;
        hipGetDevice(&dev); hipDeviceGetAttribute(&cus, hipDeviceAttributeMultiprocessorCount, dev);
        hipFuncSetAttribute((const void*)hymba_fwd, hipFuncAttributeMaxDynamicSharedMemorySize, LDS_BYTES);
        hipOccupancyMaxActiveBlocksPerMultiprocessor(&per_cu, (const void*)hymba_fwd, NTHREADS, LDS_BYTES);
        if (per_cu < 1) { fprintf(stderr, "kernel_launch: occupancy query says %d blocks/CU\n", per_cu); per_cu = 1; }
        grid = cus * per_cu;
    }
    if (grid < 0) return;
    Params p{};
    const float** pp = (const float**)&p;
    for (int i = 0; i < 22; ++i) pp[i] = (const float*)d_in[i];
    p.out = (float*)d_out; p.ws = (unsigned char*)d_ws;
    if (hipMemsetAsync(d_ws, 0, 16384, stream) != hipSuccess) { fprintf(stderr, "memset failed\n"); return; }
    void* args[] = {&p};
    hipError_t e = hipLaunchCooperativeKernel((const void*)hymba_fwd, dim3(grid), dim3(NTHREADS), args, LDS_BYTES, stream);
    if (e != hipSuccess) fprintf(stderr, "cooperative launch failed: %s (grid %d)\n", hipGetErrorString(e), grid);
}
```

```cpp
#include <hip/hip_runtime.h>
#include <hip/hip_cooperative_groups.h>
#include <cstdio>
#include <cstdint>
namespace cg = cooperative_groups;
namespace pg8 {
#define PG8_LAS __attribute__((address_space(3)))
typedef unsigned short bf16_t;
typedef short bf16x8 __attribute__((ext_vector_type(8)));
typedef float f32x4 __attribute__((ext_vector_type(4)));
typedef unsigned u32x4 __attribute__((ext_vector_type(4)));
constexpr int BM = 256, BK = 64, HALF = 128, HTB = HALF * BK * 2  , STAGE_BYTES = 8 * HTB, NXCD = 8, WGM = 8;

__host__ __device__ __forceinline__ int lds_byte(int r, int c) { const int st = (r >> 4) * 2 + (c >> 5), rr = r & 15, cc = c & 31, ob = rr * 64 + cc * 2; return st * 1024 + (ob ^ (((ob >> 9) & 1) << 5)); }
__host__ __device__ __forceinline__ void stage_rc(int b, int& R, int& C) { const int st = b / 1024, sb = b % 1024, swz = sb ^ (((sb >> 9) & 1) << 5); R = (st >> 1) * 16 + swz / 64; C = (st & 1) * 32 + (swz % 64) / 2; }
__host__ __device__ __forceinline__ int perm32(int rho) { const int n = rho >> 4, i = rho & 15; return 8 * (i >> 2) + 4 * n + (i & 3); }

struct Unit { int pm, pn, k0; };
struct Gemm { const bf16_t* A; const bf16_t* Bt; int M, N, K, KL; };

struct StaticOrder {
    int nM, nN, nwg, G, c;
    __host__ __device__ void init(int M, int N, int G_, int c_) { nM = M / BM; nN = N / BM; nwg = nM * nN; G = G_; c = c_; }
    __host__ __device__ bool next(int i, Unit& u) const {
        const long L = (long)i * G + c; if (L >= nwg) return false;
        int wgid = (int)L; { const int q = nwg / NXCD, r = nwg % NXCD, xcd = wgid % NXCD, off = wgid / NXCD; wgid = (xcd < r ? xcd * (q + 1) : r * (q + 1) + (xcd - r) * q) + off; }
        const int nig = WGM * nN, gid = wgid / nig, fm = gid * WGM, gsz = (nM - fm) < WGM ? (nM - fm) : WGM;
        u.pm = fm + ((wgid % nig) % gsz); u.pn = (wgid % nig) / gsz; u.k0 = 0; return true;
    }
    __device__ __forceinline__ void a_ready(const Unit&) const {}
    __device__ __forceinline__ void done(const Unit&) const {}
};

struct TailOrder {
    int pm0, nitems, S, KL, G, c;
    __device__ __forceinline__ bool next(int i, Unit& u) const { const int L = i * G + c; if (L >= nitems) return false; const int un = L / S, ks = L - un * S; u.pm = pm0 + (un >> 2); u.pn = un & 3; u.k0 = ks * KL; return true; }
    __device__ __forceinline__ void a_ready(const Unit&) const {}
    __device__ __forceinline__ void done(const Unit&) const {}
};

__device__ __forceinline__ unsigned cvt_pk_bf16(float lo, float hi) { unsigned r; asm volatile("v_cvt_pk_bf16_f32 %0, %1, %2" : "=v"(r) : "v"(lo), "v"(hi)); return r; }
typedef float f32x2 __attribute__((ext_vector_type(2)));
__device__ __forceinline__ f32x2 gelu_pk(f32x2 v) {
    const f32x2 av = __builtin_elementwise_abs(v), d = av * 0.2316418882f + 1.0f;
    f32x2 t; t.x = __builtin_amdgcn_rcpf(d.x); t.y = __builtin_amdgcn_rcpf(d.y);
    f32x2 q = t * 0.5307027145f + (-0.7265760135f); q = q * t + 0.7107068705f; q = q * t + (-0.142248368f); q = q * t + 0.127414796f; q = q * t;
    const f32x2 s = (v * v) * (-0.72134752044f);
    f32x2 e; e.x = __builtin_amdgcn_exp2f(s.x); e.y = __builtin_amdgcn_exp2f(s.y);
    const f32x2 m = v * (q * e), r = v - m;
    f32x2 o; o.x = v.x < 0.f ? m.x : r.x; o.y = v.y < 0.f ? m.y : r.y; return o;
}

template <int ACT  > struct EpiBf16 {
    static constexpr bool PERM = true, AFTER_DRAIN = false; static_assert(ACT == 0 || ACT == 1, "EpiBf16: ACT is 0 (none) or 1 (gelu_pk)");
    bf16_t* O; int ldc; const float* bias; int split_cols; size_t split_stride; float scale0;
    __device__ __forceinline__ void operator()(const f32x4 (&acc)[2][2][4][2], const Unit& u, int wr, int wc, int fr, int fq) const {
        const int row0 = u.pm * BM + wr * 64 + fr; int colt = u.pn * BM; bf16_t* base = O;
        float sc = 1.f; if (split_cols) { const int t = colt / split_cols; base += (size_t)t * split_stride; colt -= t * split_cols; if (t == 0) sc = scale0; }
        const int col0 = colt + wc * 32 + 8 * fq, bcol0 = u.pn * BM + wc * 32 + 8 * fq;
        f32x4 bv[2][2];
#pragma unroll
        for (int bj = 0; bj < 2; ++bj)
#pragma unroll
            for (int n = 0; n < 2; ++n) bv[bj][n] = bias ? *(const f32x4*)(bias + bcol0 + bj * HALF + 4 * n) : (f32x4){0.f, 0.f, 0.f, 0.f};
#pragma unroll
        for (int ai = 0; ai < 2; ++ai)
#pragma unroll
            for (int m = 0; m < 4; ++m) { bf16_t* rowp = base + (size_t)(row0 + ai * HALF + m * 16) * ldc + col0;
#pragma unroll
                for (int bj = 0; bj < 2; ++bj) { f32x4 v0 = acc[ai][bj][m][0] + bv[bj][0], v1 = acc[ai][bj][m][1] + bv[bj][1];
                    if (ACT == 1) { f32x2 a = gelu_pk((f32x2){v0[0], v0[1]}), b = gelu_pk((f32x2){v0[2], v0[3]}), c = gelu_pk((f32x2){v1[0], v1[1]}), d = gelu_pk((f32x2){v1[2], v1[3]});
                        v0 = (f32x4){a.x, a.y, b.x, b.y}; v1 = (f32x4){c.x, c.y, d.x, d.y}; }
                    v0 = v0 * sc; v1 = v1 * sc; u32x4 w; w.x = cvt_pk_bf16(v0[0], v0[1]); w.y = cvt_pk_bf16(v0[2], v0[3]); w.z = cvt_pk_bf16(v1[0], v1[1]); w.w = cvt_pk_bf16(v1[2], v1[3]);
                    *(u32x4*)(rowp + bj * HALF) = w; } }
    }
};
template <class Epi, class Sched, bool ALIGN_EPI = false, bool SP2 = false>
__device__ __forceinline__ void gemm_phase(PG8_LAS unsigned char* lds, const Gemm g, const Sched& S, const Epi& E) {
    int tid_o = threadIdx.x; asm volatile("" : "+v"(tid_o));
    const int tid = tid_o, wid = __builtin_amdgcn_readfirstlane(tid >> 6), lane = tid & 63, wr = wid >> 2, wc = wid & 3, fr = lane & 15, fq = lane >> 4;
    const int K = g.K, nt = g.KL / BK;
    unsigned voffA[2], voffB[2];
#pragma unroll
    for (int i = 0; i < 2; ++i) { int R, C; stage_rc(tid * 16 + i * 8192, R, C); const int Rb = Epi::PERM ? ((R & ~31) + perm32(R & 31)) : R;
        voffA[i] = (unsigned)(R * K + C) * 2u; voffB[i] = (unsigned)(Rb * K + C) * 2u; }
    const size_t kstep = (size_t)(BK * 2);
    const size_t hstep = (size_t)HALF * K * 2;
    const size_t tstep = 2 * hstep;
    const unsigned ldsw = (unsigned)wid * 1024u;
    const int aoff = lds_byte(wr * 64 + fr, fq * 8), boff = lds_byte(wc * 32 + fr, fq * 8);
#define PG8_SA(b, h) (((b) * 2 + (h)) * HTB)
#define PG8_SB(b, h) ((4 + (b) * 2 + (h)) * HTB)
#define PG8_STAGE(bufoff, gbase, voff) do { _Pragma("unroll") for (int _i = 0; _i < 2; ++_i) \
        __builtin_amdgcn_global_load_lds((const unsigned*)((const char*)(gbase) + (voff)[_i]), (PG8_LAS unsigned*)(lds + (bufoff) + ldsw + _i * 8192), 16, 0, 0); } while (0)
#define PG8_LDA(dst, b, h) do { _Pragma("unroll") for (int m = 0; m < 4; ++m) _Pragma("unroll") for (int k = 0; k < 2; ++k) dst[m][k] = *(const PG8_LAS bf16x8*)(lds + PG8_SA(b, h) + aoff + m * 2048 + k * 1024); } while (0)
#define PG8_LDB(dst, b, h) do { _Pragma("unroll") for (int n = 0; n < 2; ++n) _Pragma("unroll") for (int k = 0; k < 2; ++k) dst[n][k] = *(const PG8_LAS bf16x8*)(lds + PG8_SB(b, h) + boff + n * 2048 + k * 1024); } while (0)
#define PG8_MMA(ai, bj, At, Bt) do { __builtin_amdgcn_s_setprio(1); _Pragma("unroll") for (int m = 0; m < 4; ++m) _Pragma("unroll") for (int n = 0; n < 2; ++n) _Pragma("unroll") for (int k = 0; k < 2; ++k) \
        acc[ai][bj][m][n] = __builtin_amdgcn_mfma_f32_16x16x32_bf16(Bt[n][k], At[m][k], acc[ai][bj][m][n], 0, 0, 0); __builtin_amdgcn_s_setprio(0); } while (0)
#define PG8_WAIT_V(n) asm volatile("s_waitcnt vmcnt(" #n ")" ::: "memory")
#define PG8_WAIT_L(n) asm volatile("s_waitcnt lgkmcnt(" #n ")" ::: "memory")
#define PG8_BAR __builtin_amdgcn_s_barrier()
#define PG8_SCHED __builtin_amdgcn_sched_barrier(0)
    Unit cur, nxt; int ui = 0;
    if (!S.next(0, cur)) return;
    f32x4 acc[2][2][4][2];
#pragma unroll
    for (int a = 0; a < 2; ++a)
#pragma unroll
        for (int b = 0; b < 2; ++b)
#pragma unroll
            for (int m = 0; m < 4; ++m)
#pragma unroll
                for (int n = 0; n < 2; ++n) acc[a][b][m][n] = (f32x4){0.f, 0.f, 0.f, 0.f};
    bf16x8 At[4][2], B0[2][2], B1[2][2];
    const char* cA = (const char*)g.A + (size_t)cur.pm * tstep + (size_t)cur.k0 * 2; const char* cB = (const char*)g.Bt + (size_t)cur.pn * tstep + (size_t)cur.k0 * 2;
    S.a_ready(cur);
    if constexpr (SP2) {
        PG8_STAGE(PG8_SB(0, 0), cB, voffB); PG8_STAGE(PG8_SB(0, 1), cB + hstep, voffB); PG8_STAGE(PG8_SA(0, 0), cA, voffA); PG8_STAGE(PG8_SA(0, 1), cA + hstep, voffA);
        if (wr == 1) PG8_BAR;
        PG8_WAIT_V(2); PG8_BAR;
        PG8_STAGE(PG8_SB(1, 0), cB + kstep, voffB); PG8_STAGE(PG8_SA(1, 0), cA + kstep, voffA); PG8_STAGE(PG8_SB(1, 1), cB + hstep + kstep, voffB);
        PG8_WAIT_V(6); PG8_BAR;
    } else {
        PG8_STAGE(PG8_SB(0, 0), cB, voffB); PG8_STAGE(PG8_SA(0, 0), cA, voffA); PG8_STAGE(PG8_SB(0, 1), cB + hstep, voffB); PG8_STAGE(PG8_SA(0, 1), cA + hstep, voffA);
        if (wr == 1) PG8_BAR;
        PG8_WAIT_V(4); PG8_BAR;
        PG8_STAGE(PG8_SB(1, 0), cB + kstep, voffB); PG8_STAGE(PG8_SA(1, 0), cA + kstep, voffA); PG8_STAGE(PG8_SB(1, 1), cB + hstep + kstep, voffB);
        PG8_WAIT_V(6); PG8_BAR;
    }
    for (;;) {
        const bool has_next = S.next(ui + 1, nxt);
        const char* nA = has_next ? (const char*)g.A + (size_t)nxt.pm * tstep + (size_t)nxt.k0 * 2 : cA; const char* nB = has_next ? (const char*)g.Bt + (size_t)nxt.pn * tstep + (size_t)nxt.k0 * 2 : cB;
        for (int t = 0; t < nt; t += 2) {
            const bool last = (t == nt - 2);
            const char* a1 = cA + (size_t)(t + 1) * kstep;
            const char* a2 = last ? nA : cA + (size_t)(t + 2) * kstep; const char* b2 = last ? nB : cB + (size_t)(t + 2) * kstep;
            const char* a3 = a2 + kstep; const char* b3 = b2 + kstep;
            if (last && has_next) S.a_ready(nxt);
            if constexpr (SP2) {
            PG8_LDB(B0, 0, 0); PG8_LDB(B1, 0, 1); PG8_SCHED; PG8_LDA(At, 0, 0); PG8_STAGE(PG8_SA(1, 1), a1 + hstep, voffA);
            PG8_WAIT_V(8); PG8_WAIT_L(0); PG8_BAR; PG8_MMA(0, 0, At, B0); PG8_MMA(0, 1, At, B1); PG8_BAR; PG8_SCHED;
            PG8_LDA(At, 0, 1); PG8_STAGE(PG8_SB(0, 0), b2, voffB); PG8_STAGE(PG8_SB(0, 1), b2 + hstep, voffB); PG8_STAGE(PG8_SA(0, 0), a2, voffA);
            PG8_WAIT_V(8); PG8_WAIT_L(0); PG8_BAR; PG8_MMA(1, 0, At, B0); PG8_MMA(1, 1, At, B1); PG8_BAR; PG8_SCHED;
            PG8_LDB(B0, 1, 0); PG8_LDB(B1, 1, 1); PG8_SCHED; PG8_LDA(At, 1, 0); PG8_STAGE(PG8_SA(0, 1), a2 + hstep, voffA);
            PG8_WAIT_V(8); PG8_WAIT_L(0); PG8_BAR; PG8_MMA(0, 0, At, B0); PG8_MMA(0, 1, At, B1); PG8_BAR; PG8_SCHED;
            PG8_LDA(At, 1, 1); PG8_STAGE(PG8_SB(1, 0), b3, voffB); PG8_STAGE(PG8_SB(1, 1), b3 + hstep, voffB); PG8_STAGE(PG8_SA(1, 0), a3, voffA);
            PG8_WAIT_V(8); PG8_WAIT_L(0); PG8_BAR; PG8_MMA(1, 0, At, B0); PG8_MMA(1, 1, At, B1); PG8_BAR; PG8_SCHED;
            } else {
            PG8_LDB(B0, 0, 0); PG8_SCHED; PG8_LDA(At, 0, 0); PG8_STAGE(PG8_SA(1, 1), a1 + hstep, voffA);
            PG8_WAIT_L(8); PG8_BAR; PG8_WAIT_L(0); PG8_MMA(0, 0, At, B0); PG8_BAR; PG8_SCHED;
            PG8_LDB(B1, 0, 1); PG8_STAGE(PG8_SB(0, 0), b2, voffB);
            PG8_BAR; PG8_WAIT_L(0); PG8_MMA(0, 1, At, B1); PG8_BAR;
            PG8_LDA(At, 0, 1); PG8_STAGE(PG8_SA(0, 0), a2, voffA);
            PG8_BAR; PG8_WAIT_L(0); PG8_MMA(1, 0, At, B0); PG8_BAR; PG8_SCHED;
            PG8_STAGE(PG8_SB(0, 1), b2 + hstep, voffB);
            PG8_WAIT_V(6); PG8_BAR; PG8_MMA(1, 1, At, B1); PG8_BAR;
            PG8_LDB(B0, 1, 0); PG8_SCHED; PG8_LDA(At, 1, 0); PG8_STAGE(PG8_SA(0, 1), a2 + hstep, voffA);
            PG8_WAIT_L(8); PG8_BAR; PG8_WAIT_L(0); PG8_MMA(0, 0, At, B0); PG8_BAR; PG8_SCHED;
            PG8_LDB(B1, 1, 1); PG8_STAGE(PG8_SB(1, 0), b3, voffB);
            PG8_BAR; PG8_WAIT_L(0); PG8_MMA(0, 1, At, B1); PG8_BAR;
            PG8_LDA(At, 1, 1); PG8_STAGE(PG8_SA(1, 0), a3, voffA);
            PG8_BAR; PG8_WAIT_L(0); PG8_MMA(1, 0, At, B0); PG8_BAR; PG8_SCHED;
            PG8_STAGE(PG8_SB(1, 1), b3 + hstep, voffB);
            PG8_WAIT_V(6); PG8_BAR; PG8_MMA(1, 1, At, B1); PG8_BAR;
            }
        }
        if constexpr (ALIGN_EPI) { if (wr == 0) PG8_BAR; }
        if constexpr (!Epi::AFTER_DRAIN) { E(acc, cur, wr, wc, fr, fq); S.done(cur); }
        if (!has_next) break;
#pragma unroll
        for (int a = 0; a < 2; ++a)
#pragma unroll
            for (int b = 0; b < 2; ++b)
#pragma unroll
                for (int m = 0; m < 4; ++m)
#pragma unroll
                    for (int n = 0; n < 2; ++n) acc[a][b][m][n] = (f32x4){0.f, 0.f, 0.f, 0.f};
        cur = nxt; cA = nA; cB = nB; ++ui;
        if constexpr (ALIGN_EPI) { if (wr == 1) PG8_BAR; }
    }
    PG8_WAIT_V(0);
    if constexpr (!ALIGN_EPI) { if (wr == 0) PG8_BAR; }
    PG8_BAR;
    if constexpr (Epi::AFTER_DRAIN) { E.fused(acc, cur, wr, wc, fr, fq, lds, wid, lane); S.done(cur); }
#undef PG8_SA
#undef PG8_SB
#undef PG8_STAGE
#undef PG8_LDA
#undef PG8_LDB
#undef PG8_MMA
#undef PG8_WAIT_V
#undef PG8_WAIT_L
#undef PG8_BAR
#undef PG8_SCHED
}
}
namespace pg8 {
struct EpiResF32 {
    static constexpr bool PERM = false, AFTER_DRAIN = false;
    const float* xp; const float* xs; int split_pm; float* out; int ldc; float alpha;
    __device__ __forceinline__ void operator()(const f32x4 (&acc)[2][2][4][2], const Unit& u, int wr, int wc, int fr, int fq) const {
        const int col0 = u.pn * BM + wc * 32 + 4 * fq;
        const float* bp = (u.pm < split_pm) ? xp + (size_t)u.pm * BM * ldc : xs + (size_t)(u.pm - split_pm) * BM * ldc;
        float* op = out + (size_t)u.pm * BM * ldc;
#pragma unroll
        for (int ai = 0; ai < 2; ++ai)
#pragma unroll
            for (int m = 0; m < 4; ++m) { const size_t off = (size_t)(ai * HALF + wr * 64 + m * 16 + fr) * ldc + col0;
#pragma unroll
                for (int bj = 0; bj < 2; ++bj)
#pragma unroll
                    for (int n = 0; n < 2; ++n) { const f32x4 bs = *(const f32x4*)(bp + off + bj * HALF + n * 16); const f32x4 o = bs * alpha + acc[ai][bj][m][n]; *(f32x4*)(op + off + bj * HALF + n * 16) = o; }
                if (m & 1) asm volatile("" ::: "memory"); }
    }
};
struct EpiResBf16In {
    static constexpr bool PERM = false, AFTER_DRAIN = false;
    const bf16_t* h; float* out; int ldc; float alpha;
    __device__ __forceinline__ void operator()(const f32x4 (&acc)[2][2][4][2], const Unit& u, int wr, int wc, int fr, int fq) const {
        typedef unsigned u32x2v __attribute__((ext_vector_type(2)));
        const int col0 = u.pn * BM + wc * 32 + 4 * fq;
#pragma unroll
        for (int ai = 0; ai < 2; ++ai)
#pragma unroll
            for (int m = 0; m < 4; ++m) { const size_t off = (size_t)(u.pm * BM + ai * HALF + wr * 64 + m * 16 + fr) * ldc + col0;
#pragma unroll
                for (int bj = 0; bj < 2; ++bj)
#pragma unroll
                    for (int n = 0; n < 2; ++n) { const u32x2v hb = *(const u32x2v*)(h + off + bj * HALF + n * 16);
                        f32x4 bs; bs[0] = __uint_as_float(hb.x << 16); bs[1] = __uint_as_float(hb.x & 0xffff0000u); bs[2] = __uint_as_float(hb.y << 16); bs[3] = __uint_as_float(hb.y & 0xffff0000u);
                        const f32x4 o = bs * alpha + acc[ai][bj][m][n]; *(f32x4*)(out + off + bj * HALF + n * 16) = o; }
                if (m & 1) asm volatile("" ::: "memory"); }
    }
};
struct EpiPartF32 {
    static constexpr bool PERM = false, AFTER_DRAIN = false;
    float* part; int ldc, row0, rows, KL;
    __device__ __forceinline__ void operator()(const f32x4 (&acc)[2][2][4][2], const Unit& u, int wr, int wc, int fr, int fq) const {
        const int col0 = u.pn * BM + wc * 32 + 4 * fq; float* pb = part + (size_t)(u.k0 / KL) * rows * ldc;
#pragma unroll
        for (int ai = 0; ai < 2; ++ai)
#pragma unroll
            for (int m = 0; m < 4; ++m) { float* op = pb + (size_t)(u.pm * BM - row0 + ai * HALF + wr * 64 + m * 16 + fr) * ldc + col0;
#pragma unroll
                for (int bj = 0; bj < 2; ++bj)
#pragma unroll
                    for (int n = 0; n < 2; ++n) *(f32x4*)(op + bj * HALF + n * 16) = acc[ai][bj][m][n]; }
    }
};
struct EpiResBf16 {
    static constexpr bool PERM = true, AFTER_DRAIN = false;
    const float* xp; const bf16_t* hb; bf16_t* out; int ldc; float alpha;
    __device__ __forceinline__ void operator()(const f32x4 (&acc)[2][2][4][2], const Unit& u, int wr, int wc, int fr, int fq) const {
        const int col0 = u.pn * BM + wc * 32 + 8 * fq;
#pragma unroll
        for (int ai = 0; ai < 2; ++ai)
#pragma unroll
            for (int m = 0; m < 4; ++m) { const size_t off = (size_t)(u.pm * BM + ai * HALF + wr * 64 + m * 16 + fr) * ldc + col0;
#pragma unroll
                for (int bj = 0; bj < 2; ++bj) { f32x4 b0, b1;
                    if (xp) { b0 = *(const f32x4*)(xp + off + bj * HALF); b1 = *(const f32x4*)(xp + off + bj * HALF + 4); }
                    else { const u32x4 hw = *(const u32x4*)(hb + off + bj * HALF);
                        b0[0] = __uint_as_float(hw.x << 16); b0[1] = __uint_as_float(hw.x & 0xffff0000u); b0[2] = __uint_as_float(hw.y << 16); b0[3] = __uint_as_float(hw.y & 0xffff0000u);
                        b1[0] = __uint_as_float(hw.z << 16); b1[1] = __uint_as_float(hw.z & 0xffff0000u); b1[2] = __uint_as_float(hw.w << 16); b1[3] = __uint_as_float(hw.w & 0xffff0000u); }
                    const f32x4 v0 = b0 * alpha + acc[ai][bj][m][0], v1 = b1 * alpha + acc[ai][bj][m][1];
                    u32x4 w; w.x = cvt_pk_bf16(v0[0], v0[1]); w.y = cvt_pk_bf16(v0[2], v0[3]); w.z = cvt_pk_bf16(v1[0], v1[1]); w.w = cvt_pk_bf16(v1[2], v1[3]);
                    *(u32x4*)(out + off + bj * HALF) = w; }
                if (m & 1) asm volatile("" ::: "memory"); }
    }
};
struct EpiSwiglu {
    static constexpr bool PERM = true, AFTER_DRAIN = false;
    bf16_t* O; int ldc;
    __device__ __forceinline__ void operator()(const f32x4 (&acc)[2][2][4][2], const Unit& u, int wr, int wc, int fr, int fq) const {
        const int row0 = u.pm * BM + wr * 64 + fr; const int col0 = u.pn * HALF + wc * 32 + 8 * fq;
#pragma unroll
        for (int ai = 0; ai < 2; ++ai)
#pragma unroll
            for (int m = 0; m < 4; ++m) { bf16_t* rowp = O + (size_t)(row0 + ai * HALF + m * 16) * ldc + col0;
                float v[8];
#pragma unroll
                for (int n = 0; n < 2; ++n)
#pragma unroll
                    for (int e = 0; e < 4; ++e) { const float g = acc[ai][0][m][n][e], up = acc[ai][1][m][n][e]; v[n * 4 + e] = g * __builtin_amdgcn_rcpf(1.0f + __expf(-g)) * up; }
                u32x4 w; w.x = cvt_pk_bf16(v[0], v[1]); w.y = cvt_pk_bf16(v[2], v[3]); w.z = cvt_pk_bf16(v[4], v[5]); w.w = cvt_pk_bf16(v[6], v[7]);
                *(u32x4*)rowp = w; }
    }
};
}
#define LAS __attribute__((address_space(3)))
typedef unsigned short bf16;
typedef short bf16x8 __attribute__((ext_vector_type(8)));
typedef short s16x4 __attribute__((ext_vector_type(4)));
typedef float f32x4 __attribute__((ext_vector_type(4)));
typedef float f32x16 __attribute__((ext_vector_type(16)));
typedef unsigned u32x4 __attribute__((ext_vector_type(4)));
typedef unsigned u32x2 __attribute__((ext_vector_type(2)));

constexpr int NWAVES = 8, NTHREADS = 512;
constexpr int DM = 1024, BATCH = 8, SEQ = 4096, DEC_T = 64;
constexpr int MP = BATCH * SEQ, MS = BATCH * DEC_T, M = MP + MS;
constexpr int NCH_P = MP / 64, NCH = M / 64;
constexpr int IN_COLS = 2312, NPROJ = 2304, DFF = 2816, NGU = 2 * DFF;
constexpr int PC_Z = 0, PC_XS = 512, PC_B = 1024, PC_C = 1280, PC_Q = 1536, PC_K = 2048, PC_V = 2176;
constexpr float LN_EPS = 1e-5f, RMS_EPS = 1e-5f, ALPHA = 1.189207115002721f;
constexpr size_t MiB = 1u << 20;
constexpr size_t WS_WIN = 2 * MiB, WS_WOUT = 7 * MiB, WS_WGU = 9 * MiB, WS_WDN = 20 * MiB, WS_DT = 26 * MiB, WS_CDEC = 28 * MiB;
constexpr size_t WS_XB = 32 * MiB, WS_MIXED = WS_XB, WS_PROJ = 97 * MiB, WS_BSTATE = 244 * MiB, WS_SPREV = 374 * MiB, WS_H = 97 * MiB, WS_ACT = 162 * MiB, WS_PART = 376 * MiB, WS_PRE1 = 244 * MiB, WS_PRE2 = 32 * MiB, WS_END = 439 * MiB;
static_assert(WS_XB + (size_t)M * DM * 2 <= WS_PROJ && WS_PROJ + (size_t)M * NPROJ * 2 <= WS_BSTATE && WS_BSTATE + (size_t)NCH * 65536 * 4 <= WS_SPREV && WS_SPREV + (size_t)NCH * 65536 * 2 <= WS_END, "ws map");
static_assert(WS_H + (size_t)M * DM * 2 <= WS_ACT && WS_ACT + (size_t)M * DFF * 2 <= WS_END, "ws map 2");
constexpr size_t O_Y = 0, O_CONVP = (size_t)M * DM, O_SSMP = O_CONVP + 24576, O_KP = O_SSMP + 524288, O_VP = O_KP + 131072, O_CONVS = O_VP + 131072, O_SSMS = O_CONVS + 24576, O_KS = O_SSMS + 524288, O_VS = O_KS + 131072, O_END = O_VS + 131072;
constexpr int LDS_BYTES = 147456;

struct Params {
    const float *x_prompt, *x_sample, *state_conv, *state_ssm, *cache_k, *cache_v, *w_in, *conv_w, *conv_b, *dt_bias, *a_log, *d_skip, *ssm_norm_w, *attn_sinks,
                *w_out, *ln1_g, *ln1_b, *w_gate, *w_up, *w_down, *ln2_g, *ln2_b;
    float* out; unsigned char* ws;
};

__device__ __forceinline__ float bf2f(unsigned short h) { return __uint_as_float((unsigned)h << 16); }
__device__ __forceinline__ unsigned pk2(float lo, float hi) { return pg8::cvt_pk_bf16(lo, hi); }
__device__ __forceinline__ float wave_sum(float v) {
#pragma unroll
    for (int o = 1; o < 64; o <<= 1) v += __shfl_xor(v, o);
    return v;
}
__device__ __forceinline__ float silu_f(float v) { return v * __builtin_amdgcn_rcpf(1.0f + __expf(-v)); }
__device__ __forceinline__ void unpack8(const u32x4 w, float (&f)[8]) {
    f[0] = __uint_as_float(w.x << 16); f[1] = __uint_as_float(w.x & 0xffff0000u); f[2] = __uint_as_float(w.y << 16); f[3] = __uint_as_float(w.y & 0xffff0000u);
    f[4] = __uint_as_float(w.z << 16); f[5] = __uint_as_float(w.z & 0xffff0000u); f[6] = __uint_as_float(w.w << 16); f[7] = __uint_as_float(w.w & 0xffff0000u);
}

__device__ __forceinline__ void p0_item(const float* W, int ldw, int k0, int nsrc0, bf16* WT, int K, int drow0, LAS float* scr, int lane) {
#pragma unroll 8
    for (int i = 0; i < 32; ++i) { const int kk = 2 * i + (lane >> 5); scr[kk * 33 + (lane & 31)] = W[(size_t)(k0 + kk) * ldw + nsrc0 + (lane & 31)]; }
    asm volatile("s_waitcnt lgkmcnt(0)" ::: "memory");
    const int c = lane & 7;
#pragma unroll
    for (int j = 0; j < 4; ++j) { const int n = (lane >> 3) + 8 * j; const LAS float* s = scr + (8 * c) * 33 + n;
        u32x4 o; o.x = pk2(s[0 * 33], s[1 * 33]); o.y = pk2(s[2 * 33], s[3 * 33]); o.z = pk2(s[4 * 33], s[5 * 33]); o.w = pk2(s[6 * 33], s[7 * 33]);
        *(u32x4*)(WT + (size_t)(drow0 + n) * K + k0 + 8 * c) = o; }
    asm volatile("s_waitcnt lgkmcnt(0)" ::: "memory");
}

__device__ __forceinline__ void p0_prologue(const Params& P, LAS unsigned char* lds, int tid, int lane, int wave, int G) {
    unsigned char* ws = P.ws;
    bf16* WIN = (bf16*)(ws + WS_WIN); bf16* WOUT = (bf16*)(ws + WS_WOUT); bf16* WGU = (bf16*)(ws + WS_WGU); bf16* WDN = (bf16*)(ws + WS_WDN);
    bf16* XB = (bf16*)(ws + WS_XB); float* DT = (float*)(ws + WS_DT);
    LAS float* scr = (LAS float*)(lds + wave * 8448);
    LAS float* wdt = (LAS float*)(lds + 73728);
    for (int i = tid; i < 8192; i += NTHREADS) { const int k = i >> 3, h = i & 7; wdt[h * 1024 + k] = P.w_in[(size_t)k * IN_COLS + 1536 + h]; }
    const int gw = blockIdx.x * NWAVES + wave, NGW = G * NWAVES;
    constexpr int I_IN = 16 * 72, I_OUT = 16 * 32, I_GU = 16 * 176, I_DN = 44 * 32, NITEMS = I_IN + I_OUT + I_GU + I_DN;
    for (int it = gw; it < NITEMS; it += NGW) {
        int r = it;
        if (r < I_IN) { const int kb = r / 72, nb = r % 72, n0 = 32 * nb; p0_item(P.w_in, IN_COLS, 64 * kb, n0 + (n0 >= 1536 ? 8 : 0), WIN, DM, n0, scr, lane); continue; } r -= I_IN;
        if (r < I_OUT) { const int kb = r / 32, nb = r % 32; p0_item(P.w_out, DM, 64 * kb, 32 * nb, WOUT, DM, 32 * nb, scr, lane); continue; } r -= I_OUT;
        if (r < I_GU) { const int kb = r / 176, nb = r % 176, t = nb >> 3, s = (nb >> 2) & 1, i0 = 32 * (nb & 3); p0_item(s ? P.w_up : P.w_gate, DFF, 64 * kb, 128 * t + i0, WGU, DM, 32 * nb, scr, lane); continue; } r -= I_GU;
        { const int kb = r / 32, nb = r % 32; p0_item(P.w_down, DM, 64 * kb, 32 * nb, WDN, DFF, 32 * nb, scr, lane); }
    }
    __syncthreads();
    float bias = 0.f; if (lane < 8) bias = P.dt_bias[lane];
    for (int m = gw; m < M; m += NGW) {
        const float* xrow = (m < MP) ? P.x_prompt + (size_t)m * DM : P.x_sample + (size_t)(m - MP) * DM;
        f32x4 v[4];
#pragma unroll
        for (int j = 0; j < 4; ++j) v[j] = *(const f32x4*)(xrow + 4 * lane + 256 * j);
        unsigned long long* o8 = (unsigned long long*)(XB + (size_t)m * DM) + lane;
#pragma unroll
        for (int j = 0; j < 4; ++j) o8[64 * j] = (unsigned long long)pk2(v[j][0], v[j][1]) | ((unsigned long long)pk2(v[j][2], v[j][3]) << 32);
        float mine = 0.f;
#pragma unroll
        for (int h = 0; h < 8; ++h) { float a = 0.f;
#pragma unroll
            for (int j = 0; j < 4; ++j) { const f32x4 w = *(const LAS f32x4*)(wdt + h * 1024 + 4 * lane + 256 * j); a += v[j][0] * w[0] + v[j][1] * w[1] + v[j][2] * w[2] + v[j][3] * w[3]; }
            a = wave_sum(a); if (lane == h) mine = a; }
        if (lane < 8) { const float xx = mine + bias; DT[(size_t)m * 8 + lane] = (xx > 20.f) ? xx : log1pf(__expf(xx)); }
    }
}

__device__ __forceinline__ void conv8x4(const Params& P, const bf16* PROJ, int cid, int pcol, int cch, int t0, float (&o)[4][8]) {
    const bool sample = cid >= NCH_P; const bool has_prev = (!sample) && ((cid & 63) != 0);
    const size_t m0 = (size_t)cid * 64;
    float xin[7][8];
#pragma unroll
    for (int rr = 0; rr < 7; ++rr) { const int lt = t0 - 3 + rr;
        if (lt >= 0 || has_prev) { const u32x4 w = *(const u32x4*)(PROJ + (size_t)((long)m0 + lt) * NPROJ + pcol); unpack8(w, xin[rr]); }
        else if (sample) { const float* sc = P.state_conv + ((size_t)(cid - NCH_P) * 3 + (lt + 3)) * 1024 + cch; const f32x4 a = *(const f32x4*)sc, b = *(const f32x4*)(sc + 4);
            xin[rr][0] = a[0]; xin[rr][1] = a[1]; xin[rr][2] = a[2]; xin[rr][3] = a[3]; xin[rr][4] = b[0]; xin[rr][5] = b[1]; xin[rr][6] = b[2]; xin[rr][7] = b[3]; }
        else {
#pragma unroll
            for (int e = 0; e < 8; ++e) xin[rr][e] = 0.f; } }
    float cw[4][8], cb[8];
#pragma unroll
    for (int i = 0; i < 4; ++i) { const f32x4 a = *(const f32x4*)(P.conv_w + i * 1024 + cch), b = *(const f32x4*)(P.conv_w + i * 1024 + cch + 4);
        cw[i][0] = a[0]; cw[i][1] = a[1]; cw[i][2] = a[2]; cw[i][3] = a[3]; cw[i][4] = b[0]; cw[i][5] = b[1]; cw[i][6] = b[2]; cw[i][7] = b[3]; }
    { const f32x4 a = *(const f32x4*)(P.conv_b + cch), b = *(const f32x4*)(P.conv_b + cch + 4); cb[0] = a[0]; cb[1] = a[1]; cb[2] = a[2]; cb[3] = a[3]; cb[4] = b[0]; cb[5] = b[1]; cb[6] = b[2]; cb[7] = b[3]; }
#pragma unroll
    for (int tt = 0; tt < 4; ++tt)
#pragma unroll
        for (int e = 0; e < 8; ++e) { float a = cb[e];
#pragma unroll
            for (int i = 0; i < 4; ++i) a += cw[i][e] * xin[tt + i][e];
            o[tt][e] = silu_f(a); }
}

constexpr int KS_STR = 72, VT_STR = 200;
__device__ __forceinline__ void attn_unit(const Params& P, LAS unsigned char* lds, int cid, int kv, int tid, int lane, int wave) {
    asm volatile("" : "+v"(tid), "+v"(lane));
    const bf16* PROJ = (const bf16*)(P.ws + WS_PROJ); bf16* MIXED = (bf16*)(P.ws + WS_MIXED);
    LAS bf16* Ks = (LAS bf16*)lds; LAS bf16* VT = (LAS bf16*)(lds + 192 * KS_STR * 2);
    const bool sample = cid >= NCH_P; const int c = cid & 63; const size_t m0 = (size_t)cid * 64;
    for (int idx = tid; idx < 1536; idx += NTHREADS) { const int j = idx >> 3, ch = idx & 7;
        u32x4 k8 = (u32x4){0u, 0u, 0u, 0u}, v8 = (u32x4){0u, 0u, 0u, 0u};
        if (sample && j < 128) { const size_t o = (((size_t)(cid - NCH_P) * 128 + j) * 2 + kv) * 64 + ch * 8;
            const f32x4 a = *(const f32x4*)(P.cache_k + o), b = *(const f32x4*)(P.cache_k + o + 4), cc = *(const f32x4*)(P.cache_v + o), d = *(const f32x4*)(P.cache_v + o + 4);
            k8.x = pk2(a[0], a[1]); k8.y = pk2(a[2], a[3]); k8.z = pk2(b[0], b[1]); k8.w = pk2(b[2], b[3]);
            v8.x = pk2(cc[0], cc[1]); v8.y = pk2(cc[2], cc[3]); v8.z = pk2(d[0], d[1]); v8.w = pk2(d[2], d[3]); }
        else if (sample || (c * 64 - 128 + j >= 0)) { const bf16* rp = PROJ + (size_t)((long)m0 - 128 + j) * NPROJ + kv * 64 + ch * 8; k8 = *(const u32x4*)(rp + PC_K); v8 = *(const u32x4*)(rp + PC_V); }
        *(LAS u32x4*)(Ks + j * KS_STR + ch * 8) = k8;
        LAS bf16* vp = VT + (ch * 8) * VT_STR + j;
        vp[0 * VT_STR] = (bf16)(v8.x & 0xffff); vp[1 * VT_STR] = (bf16)(v8.x >> 16); vp[2 * VT_STR] = (bf16)(v8.y & 0xffff); vp[3 * VT_STR] = (bf16)(v8.y >> 16);
        vp[4 * VT_STR] = (bf16)(v8.z & 0xffff); vp[5 * VT_STR] = (bf16)(v8.z >> 16); vp[6 * VT_STR] = (bf16)(v8.w & 0xffff); vp[7 * VT_STR] = (bf16)(v8.w >> 16); }
    __syncthreads();
    const int r = wave >> 1, th = wave & 1, hq = kv * 4 + r, l31 = lane & 31, hh = lane >> 5; int tq = 32 * th + l31; asm volatile("" : "+v"(tq));
    const bf16* qp = PROJ + (m0 + tq) * NPROJ + PC_Q + hq * 64 + 8 * hh;
    bf16x8 qf[4];
#pragma unroll
    for (int ks = 0; ks < 4; ++ks) qf[ks] = *(const bf16x8*)(qp + 16 * ks);
    f32x16 sacc[6];
#pragma unroll
    for (int kt = 0; kt < 6; ++kt) {
#pragma unroll
        for (int i = 0; i < 16; ++i) sacc[kt][i] = 0.f;
#pragma unroll
        for (int ks = 0; ks < 4; ++ks) { const bf16x8 a = *(const LAS bf16x8*)(Ks + (32 * kt + l31) * KS_STR + 16 * ks + 8 * hh); sacc[kt] = __builtin_amdgcn_mfma_f32_32x32x16_bf16(a, qf[ks], sacc[kt], 0, 0, 0); }
        __builtin_amdgcn_sched_barrier(0); }
    const float slope = exp2f(-(float)(hq + 1)), sink = P.attn_sinks[hq];
    float mx = sink;
#pragma unroll
    for (int kt = 0; kt < 6; ++kt) { const bool valid = sample || (2 * c + kt >= 4);
#pragma unroll
        for (int i = 0; i < 16; ++i) { const int key = 32 * kt + (i & 3) + 8 * (i >> 2) + 4 * hh; const float dist = fabsf((float)(128 + tq - key));
            const float s = valid ? (sacc[kt][i] * 0.125f - slope * dist) : -INFINITY; sacc[kt][i] = s; mx = fmaxf(mx, s); }
        __builtin_amdgcn_sched_barrier(0); }
    mx = fmaxf(mx, __shfl_xor(mx, 32));
    float sum = 0.f;
#pragma unroll
    for (int kt = 0; kt < 6; ++kt)
#pragma unroll
        for (int i = 0; i < 16; ++i) { const float p = __expf(sacc[kt][i] - mx); sacc[kt][i] = p; sum += p; }
    sum += __shfl_xor(sum, 32);
    const float inv = 1.0f / (sum + __expf(sink - mx));
    f32x16 oacc[2];
#pragma unroll
    for (int d2 = 0; d2 < 2; ++d2)
#pragma unroll
        for (int i = 0; i < 16; ++i) oacc[d2][i] = 0.f;
#pragma unroll
    for (int kt = 0; kt < 6; ++kt)
#pragma unroll
        for (int s2 = 0; s2 < 2; ++s2) {
            union { u32x4 u; bf16x8 v; } pf;
            pf.u.x = pk2(sacc[kt][8 * s2 + 0], sacc[kt][8 * s2 + 1]); pf.u.y = pk2(sacc[kt][8 * s2 + 2], sacc[kt][8 * s2 + 3]);
            pf.u.z = pk2(sacc[kt][8 * s2 + 4], sacc[kt][8 * s2 + 5]); pf.u.w = pk2(sacc[kt][8 * s2 + 6], sacc[kt][8 * s2 + 7]);
#pragma unroll
            for (int d2 = 0; d2 < 2; ++d2) { const LAS bf16* vp = VT + (32 * d2 + l31) * VT_STR + 32 * kt + 16 * s2 + 4 * hh;
                union { u32x4 u; bf16x8 v; } af; const u32x2 lo = *(const LAS u32x2*)vp, hi = *(const LAS u32x2*)(vp + 8); af.u.x = lo.x; af.u.y = lo.y; af.u.z = hi.x; af.u.w = hi.y;
                oacc[d2] = __builtin_amdgcn_mfma_f32_32x32x16_bf16(af.v, pf.v, oacc[d2], 0, 0, 0); }
            __builtin_amdgcn_sched_barrier(0); }
    bf16* op = MIXED + (m0 + tq) * DM + 512 + hq * 64 + 4 * hh;
#pragma unroll
    for (int d2 = 0; d2 < 2; ++d2)
#pragma unroll
        for (int rg = 0; rg < 4; ++rg) { u32x2 w; w.x = pk2(oacc[d2][4 * rg] * inv, oacc[d2][4 * rg + 1] * inv); w.y = pk2(oacc[d2][4 * rg + 2] * inv, oacc[d2][4 * rg + 3] * inv);
            *(u32x2*)(op + 32 * d2 + 8 * rg) = w; }
    __syncthreads();
}

constexpr int XT_STR = 72, BM_STR = 136, CB_STR = 68;
__device__ __forceinline__ float wave_incl_scan(float v, int lane) {
#pragma unroll
    for (int o = 1; o < 64; o <<= 1) { const float t = __shfl_up(v, o); if (lane >= o) v += t; }
    return v;
}
__device__ __forceinline__ void bstate_unit(const Params& P, LAS unsigned char* lds, int cid, int g, int tid, int lane, int wave) {
    asm volatile("" : "+v"(tid), "+v"(lane));
    const bf16* PROJ = (const bf16*)(P.ws + WS_PROJ); const float* DT = (const float*)(P.ws + WS_DT); float* CDEC = (float*)(P.ws + WS_CDEC); float* BST = (float*)(P.ws + WS_BSTATE);
    LAS bf16* xsT = (LAS bf16*)lds;
    LAS bf16* BmT = (LAS bf16*)(lds + 256 * XT_STR * 2);
    LAS float* wsc = (LAS float*)(lds + 256 * XT_STR * 2 + 128 * XT_STR * 2);
    const size_t m0 = (size_t)cid * 64;
    if (wave < 4) { const int h = 4 * g + wave; const float dt = DT[(m0 + lane) * 8 + h]; const float a = -__expf(P.a_log[h]);
        const float cum = wave_incl_scan(dt * a, lane); const float tot = __shfl(cum, 63);
        wsc[wave * 64 + lane] = dt * __expf(tot - cum); if (lane == 63) CDEC[cid * 8 + h] = __expf(tot); }
    __syncthreads();
    { const int cg8 = tid & 31, seg = tid >> 5, t0 = 4 * seg; float o[4][8];
        conv8x4(P, PROJ, cid, PC_XS + 256 * g + 8 * cg8, 256 * g + 8 * cg8, t0, o);
        const int hh = cg8 >> 3; const f32x4 w4 = *(const LAS f32x4*)(wsc + hh * 64 + t0);
#pragma unroll
        for (int e = 0; e < 8; ++e) { u32x2 w; w.x = pk2(o[0][e] * w4[0], o[1][e] * w4[1]); w.y = pk2(o[2][e] * w4[2], o[3][e] * w4[3]); *(LAS u32x2*)(xsT + (8 * cg8 + e) * XT_STR + t0) = w; } }
    if (tid < 256) { const int cg8 = tid & 15, seg = tid >> 4, t0 = 4 * seg; float o[4][8];
        conv8x4(P, PROJ, cid, PC_B + 128 * g + 8 * cg8, 512 + 128 * g + 8 * cg8, t0, o);
#pragma unroll
        for (int e = 0; e < 8; ++e) { u32x2 w; w.x = pk2(o[0][e], o[1][e]); w.y = pk2(o[2][e], o[3][e]); *(LAS u32x2*)(BmT + (8 * cg8 + e) * XT_STR + t0) = w; } }
    __syncthreads();
    const int hh = wave >> 1, ph = wave & 1, h = 4 * g + hh, fr = lane & 15, fq = lane >> 4;
    f32x4 acc[2][8];
#pragma unroll
    for (int pt = 0; pt < 2; ++pt)
#pragma unroll
        for (int nt = 0; nt < 8; ++nt) acc[pt][nt] = (f32x4){0.f, 0.f, 0.f, 0.f};
#pragma unroll
    for (int ks = 0; ks < 2; ++ks) { bf16x8 a[2];
#pragma unroll
        for (int pt = 0; pt < 2; ++pt) a[pt] = *(const LAS bf16x8*)(xsT + (64 * hh + 32 * ph + 16 * pt + fr) * XT_STR + 32 * ks + 8 * fq);
#pragma unroll
        for (int nt = 0; nt < 8; ++nt) { const bf16x8 b = *(const LAS bf16x8*)(BmT + (16 * nt + fr) * XT_STR + 32 * ks + 8 * fq);
#pragma unroll
            for (int pt = 0; pt < 2; ++pt) acc[pt][nt] = __builtin_amdgcn_mfma_f32_16x16x32_bf16(a[pt], b, acc[pt][nt], 0, 0, 0); } }
    float* bp = BST + ((size_t)cid * 8 + h) * 8192;
#pragma unroll
    for (int pt = 0; pt < 2; ++pt)
#pragma unroll
        for (int nt = 0; nt < 8; ++nt)
#pragma unroll
            for (int i = 0; i < 4; ++i) bp[(32 * ph + 16 * pt + 4 * fq + i) * 128 + 16 * nt + fr] = acc[pt][nt][i];
    __syncthreads();
}

__device__ __forceinline__ void p3_scan(const Params& P, int tid, int G) {
    asm volatile("" : "+v"(tid));
    const float* CDEC = (const float*)(P.ws + WS_CDEC); const float* BST = (const float*)(P.ws + WS_BSTATE); bf16* SPV = (bf16*)(P.ws + WS_SPREV); const bf16* PROJ = (const bf16*)(P.ws + WS_PROJ);
    const int gt = blockIdx.x * NTHREADS + tid, NT = G * NTHREADS;
    for (int item = gt; item < 131072; item += NT) { const int b = item >> 14, e = item & 16383, h = e >> 11; const size_t eo = (size_t)e * 4;
        f32x4 s = (f32x4){0.f, 0.f, 0.f, 0.f};
        for (int c0 = 0; c0 < 64; c0 += 8) { f32x4 bs[8]; float dc[8];
#pragma unroll
            for (int u = 0; u < 8; ++u) { const size_t cid = (size_t)b * 64 + c0 + u; bs[u] = *(const f32x4*)(BST + cid * 65536 + eo); dc[u] = CDEC[cid * 8 + h]; }
#pragma unroll
            for (int u = 0; u < 8; ++u) { const size_t cid = (size_t)b * 64 + c0 + u; u32x2 w; w.x = pk2(s[0], s[1]); w.y = pk2(s[2], s[3]); *(u32x2*)(SPV + cid * 65536 + eo) = w; s = s * dc[u] + bs[u]; } }
        *(f32x4*)(P.out + O_SSMP + (size_t)b * 65536 + eo) = s;
        { const size_t cid = NCH_P + b; const f32x4 s0 = *(const f32x4*)(P.state_ssm + (size_t)b * 65536 + eo); u32x2 w; w.x = pk2(s0[0], s0[1]); w.y = pk2(s0[2], s0[3]); *(u32x2*)(SPV + cid * 65536 + eo) = w;
            *(f32x4*)(P.out + O_SSMS + (size_t)b * 65536 + eo) = s0 * CDEC[cid * 8 + h] + *(const f32x4*)(BST + cid * 65536 + eo); } }
    for (int i = gt; i < 24576; i += NT) { const int b = i / 3072, r = (i / 1024) % 3, ch = i & 1023;
        P.out[O_CONVP + i] = bf2f(PROJ[((size_t)b * SEQ + SEQ - 3 + r) * NPROJ + PC_XS + ch]);
        P.out[O_CONVS + i] = bf2f(PROJ[((size_t)MP + b * 64 + 61 + r) * NPROJ + PC_XS + ch]); }
    for (int i = gt; i < 131072; i += NT) { const int b = i >> 14, j = (i >> 7) & 127, kd = i & 127;
        const size_t rp = ((size_t)b * SEQ + SEQ - 128 + j) * NPROJ;
        P.out[O_KP + i] = bf2f(PROJ[rp + PC_K + kd]); P.out[O_VP + i] = bf2f(PROJ[rp + PC_V + kd]);
        if (j < 64) { const size_t o = ((size_t)b * 128 + j + 64) * 128 + kd; P.out[O_KS + i] = P.cache_k[o]; P.out[O_VS + i] = P.cache_v[o]; }
        else { const size_t rs = ((size_t)MP + b * 64 + j - 64) * NPROJ; P.out[O_KS + i] = bf2f(PROJ[rs + PC_K + kd]); P.out[O_VS + i] = bf2f(PROJ[rs + PC_V + kd]); } }
}

constexpr int YT_STR = 260;
__device__ __forceinline__ void ssd_unit(const Params& P, LAS unsigned char* lds, int cid, int g, int tid, int lane, int wave) {
    asm volatile("" : "+v"(tid), "+v"(lane));
    const bf16* PROJ = (const bf16*)(P.ws + WS_PROJ); const float* DT = (const float*)(P.ws + WS_DT); const bf16* SPV = (const bf16*)(P.ws + WS_SPREV); bf16* MIXED = (bf16*)(P.ws + WS_MIXED);
    LAS bf16* xsT = (LAS bf16*)lds;
    LAS bf16* Bm = (LAS bf16*)(lds + 36864);
    LAS bf16* Cm = (LAS bf16*)(lds + 36864 + 17408);
    LAS float* CB = (LAS float*)(lds + 36864 + 2 * 17408);
    LAS float* dts = (LAS float*)(lds + 36864 + 3 * 17408);
    LAS float* cums = dts + 256;
    LAS float* yt = (LAS float*)lds;
    const size_t m0 = (size_t)cid * 64;
    if (wave < 4) { const int h = 4 * g + wave; const float dt = DT[(m0 + lane) * 8 + h]; const float a = -__expf(P.a_log[h]);
        const float cum = wave_incl_scan(dt * a, lane); dts[wave * 64 + lane] = dt; cums[wave * 64 + lane] = cum; }
    { const int cg8 = tid & 31, seg = tid >> 5, t0 = 4 * seg; float o[4][8];
        conv8x4(P, PROJ, cid, PC_XS + 256 * g + 8 * cg8, 256 * g + 8 * cg8, t0, o);
#pragma unroll
        for (int e = 0; e < 8; ++e) { u32x2 w; w.x = pk2(o[0][e], o[1][e]); w.y = pk2(o[2][e], o[3][e]); *(LAS u32x2*)(xsT + (8 * cg8 + e) * XT_STR + t0) = w; }
        const int isC = cg8 >> 4, c16 = cg8 & 15;
        conv8x4(P, PROJ, cid, (isC ? PC_C : PC_B) + 128 * g + 8 * c16, (isC ? 768 : 512) + 128 * g + 8 * c16, t0, o);
        LAS bf16* dst = isC ? Cm : Bm;
#pragma unroll
        for (int tt = 0; tt < 4; ++tt) { u32x4 w; w.x = pk2(o[tt][0], o[tt][1]); w.y = pk2(o[tt][2], o[tt][3]); w.z = pk2(o[tt][4], o[tt][5]); w.w = pk2(o[tt][6], o[tt][7]); *(LAS u32x4*)(dst + (t0 + tt) * BM_STR + 8 * c16) = w; } }
    __syncthreads();
    const int fr = lane & 15, fq = lane >> 4;
    { const int lt = wave >> 1, st0 = 2 * (wave & 1); f32x4 ca[2] = {(f32x4){0.f, 0.f, 0.f, 0.f}, (f32x4){0.f, 0.f, 0.f, 0.f}};
#pragma unroll
        for (int ks = 0; ks < 4; ++ks) { const bf16x8 a = *(const LAS bf16x8*)(Cm + (16 * lt + fr) * BM_STR + 32 * ks + 8 * fq);
#pragma unroll
            for (int u = 0; u < 2; ++u) { const bf16x8 b = *(const LAS bf16x8*)(Bm + (16 * (st0 + u) + fr) * BM_STR + 32 * ks + 8 * fq); ca[u] = __builtin_amdgcn_mfma_f32_16x16x32_bf16(a, b, ca[u], 0, 0, 0); } }
#pragma unroll
        for (int u = 0; u < 2; ++u)
#pragma unroll
            for (int i = 0; i < 4; ++i) CB[(16 * lt + 4 * fq + i) * CB_STR + 16 * (st0 + u) + fr] = ca[u][i]; }
    __syncthreads();
    const int hh = wave >> 1, ph = wave & 1, h = 4 * g + hh;
    f32x4 acc[4][2];
#pragma unroll
    for (int lt = 0; lt < 4; ++lt)
#pragma unroll
        for (int pt = 0; pt < 2; ++pt) acc[lt][pt] = (f32x4){0.f, 0.f, 0.f, 0.f};
    {
        bf16x8 sb[2][4]; const bf16* sp = SPV + (((size_t)cid * 8 + h) * 64 + 32 * ph + fr) * 128 + 8 * fq;
#pragma unroll
        for (int pt = 0; pt < 2; ++pt)
#pragma unroll
            for (int ks = 0; ks < 4; ++ks) sb[pt][ks] = *(const bf16x8*)(sp + (size_t)pt * 16 * 128 + 32 * ks);
#pragma unroll
        for (int lt = 0; lt < 4; ++lt)
#pragma unroll
            for (int ks = 0; ks < 4; ++ks) { const bf16x8 a = *(const LAS bf16x8*)(Cm + (16 * lt + fr) * BM_STR + 32 * ks + 8 * fq);
#pragma unroll
                for (int pt = 0; pt < 2; ++pt) acc[lt][pt] = __builtin_amdgcn_mfma_f32_16x16x32_bf16(a, sb[pt][ks], acc[lt][pt], 0, 0, 0); }
#pragma unroll
        for (int lt = 0; lt < 4; ++lt) { const f32x4 c4 = *(const LAS f32x4*)(cums + hh * 64 + 16 * lt + 4 * fq);
#pragma unroll
            for (int i = 0; i < 4; ++i) { const float e = __expf(c4[i]); acc[lt][0][i] *= e; acc[lt][1][i] *= e; } }
    }
#pragma unroll
    for (int lt = 0; lt < 4; ++lt)
#pragma unroll
        for (int ks = 0; ks < 2; ++ks) { if (32 * ks > 16 * lt + 15) continue;
            const int l = 16 * lt + fr, s0 = 32 * ks + 8 * fq; const float cl = cums[hh * 64 + l];
            const f32x4 cb0 = *(const LAS f32x4*)(CB + l * CB_STR + s0), cb1 = *(const LAS f32x4*)(CB + l * CB_STR + s0 + 4);
            const f32x4 cs0 = *(const LAS f32x4*)(cums + hh * 64 + s0), cs1 = *(const LAS f32x4*)(cums + hh * 64 + s0 + 4);
            const f32x4 d0 = *(const LAS f32x4*)(dts + hh * 64 + s0), d1 = *(const LAS f32x4*)(dts + hh * 64 + s0 + 4);
            float mv[8];
#pragma unroll
            for (int j = 0; j < 4; ++j) { mv[j] = (s0 + j <= l) ? cb0[j] * __expf(fminf(cl - cs0[j], 0.f)) * d0[j] : 0.f; mv[4 + j] = (s0 + 4 + j <= l) ? cb1[j] * __expf(fminf(cl - cs1[j], 0.f)) * d1[j] : 0.f; }
            union { u32x4 u; bf16x8 v; } af; af.u.x = pk2(mv[0], mv[1]); af.u.y = pk2(mv[2], mv[3]); af.u.z = pk2(mv[4], mv[5]); af.u.w = pk2(mv[6], mv[7]);
#pragma unroll
            for (int pt = 0; pt < 2; ++pt) { const bf16x8 b = *(const LAS bf16x8*)(xsT + (64 * hh + 32 * ph + 16 * pt + fr) * XT_STR + s0); acc[lt][pt] = __builtin_amdgcn_mfma_f32_16x16x32_bf16(af.v, b, acc[lt][pt], 0, 0, 0); } }
    { const float dsk = P.d_skip[h];
#pragma unroll
        for (int lt = 0; lt < 4; ++lt)
#pragma unroll
            for (int pt = 0; pt < 2; ++pt) { const u32x2 xw = *(const LAS u32x2*)(xsT + (64 * hh + 32 * ph + 16 * pt + fr) * XT_STR + 16 * lt + 4 * fq);
                acc[lt][pt][0] += dsk * __uint_as_float(xw.x << 16); acc[lt][pt][1] += dsk * __uint_as_float(xw.x & 0xffff0000u); acc[lt][pt][2] += dsk * __uint_as_float(xw.y << 16); acc[lt][pt][3] += dsk * __uint_as_float(xw.y & 0xffff0000u); } }
    __syncthreads();
#pragma unroll
    for (int lt = 0; lt < 4; ++lt)
#pragma unroll
        for (int pt = 0; pt < 2; ++pt)
#pragma unroll
            for (int i = 0; i < 4; ++i) yt[(16 * lt + 4 * fq + i) * YT_STR + 64 * hh + 32 * ph + 16 * pt + fr] = acc[lt][pt][i];
    __syncthreads();
    const f32x4 nw = *(const f32x4*)(P.ssm_norm_w + 256 * g + 4 * lane);
#pragma unroll
    for (int q = 0; q < 8; ++q) { const int l = 8 * wave + q; const f32x4 y = *(const LAS f32x4*)(yt + l * YT_STR + 4 * lane);
        const u32x2 zw = *(const u32x2*)(PROJ + (m0 + l) * NPROJ + PC_Z + 256 * g + 4 * lane);
        f32x4 gg; gg[0] = y[0] * silu_f(__uint_as_float(zw.x << 16)); gg[1] = y[1] * silu_f(__uint_as_float(zw.x & 0xffff0000u)); gg[2] = y[2] * silu_f(__uint_as_float(zw.y << 16)); gg[3] = y[3] * silu_f(__uint_as_float(zw.y & 0xffff0000u));
        const float ss = wave_sum(gg[0] * gg[0] + gg[1] * gg[1] + gg[2] * gg[2] + gg[3] * gg[3]); const float rs = 1.0f / sqrtf(ss * (1.0f / 256.0f) + RMS_EPS);
        u32x2 w; w.x = pk2(gg[0] * rs * nw[0], gg[1] * rs * nw[1]); w.y = pk2(gg[2] * rs * nw[2], gg[3] * rs * nw[3]);
        *(u32x2*)(MIXED + (m0 + l) * DM + 256 * g + 4 * lane) = w; }
    __syncthreads();
}

__device__ __forceinline__ void ln_rows(const bf16* in, const float* gam, const float* bet, bf16* obf, float* of32, const float* part, int nparts, const float* xs, const bf16* hb, int lane, int wave, int G) {
    asm volatile("" : "+v"(lane));
    const int gw = blockIdx.x * NWAVES + wave, NGW = G * NWAVES;
    f32x4 gv[4], bv[4];
#pragma unroll
    for (int j = 0; j < 4; ++j) { gv[j] = *(const f32x4*)(gam + 4 * lane + 256 * j); bv[j] = *(const f32x4*)(bet + 4 * lane + 256 * j); }
    for (int m = gw; m < M; m += NGW) {
        f32x4 v[4]; float s = 0.f;
        if (m < MP) { const bf16* xr = in + (size_t)m * DM + 4 * lane;
#pragma unroll
            for (int j = 0; j < 4; ++j) { const u32x2 hw = *(const u32x2*)(xr + 256 * j); v[j][0] = __uint_as_float(hw.x << 16); v[j][1] = __uint_as_float(hw.x & 0xffff0000u); v[j][2] = __uint_as_float(hw.y << 16); v[j][3] = __uint_as_float(hw.y & 0xffff0000u); } }
        else { const size_t ro = (size_t)(m - MP) * DM + 4 * lane;
#pragma unroll
            for (int j = 0; j < 4; ++j) { if (xs) v[j] = *(const f32x4*)(xs + ro + 256 * j) * ALPHA;
                else { const u32x2 hw = *(const u32x2*)(hb + (size_t)m * DM + 4 * lane + 256 * j); v[j][0] = ALPHA * __uint_as_float(hw.x << 16); v[j][1] = ALPHA * __uint_as_float(hw.x & 0xffff0000u); v[j][2] = ALPHA * __uint_as_float(hw.y << 16); v[j][3] = ALPHA * __uint_as_float(hw.y & 0xffff0000u); } }
            for (int sp = 0; sp < nparts; ++sp) { const float* pr = part + (size_t)sp * MS * DM + ro;
#pragma unroll
                for (int j = 0; j < 4; ++j) v[j] = v[j] + *(const f32x4*)(pr + 256 * j); } }
#pragma unroll
        for (int j = 0; j < 4; ++j) s += (v[j][0] + v[j][1]) + (v[j][2] + v[j][3]);
        const float mean = wave_sum(s) * (1.f / DM); float s2 = 0.f;
#pragma unroll
        for (int j = 0; j < 4; ++j) { v[j] = v[j] - mean; s2 += (v[j][0] * v[j][0] + v[j][1] * v[j][1]) + (v[j][2] * v[j][2] + v[j][3] * v[j][3]); }
        const float rstd = 1.f / sqrtf(wave_sum(s2) * (1.f / DM) + LN_EPS);
#pragma unroll
        for (int j = 0; j < 4; ++j) { const f32x4 o = v[j] * rstd * gv[j] + bv[j];
            if (obf) { u32x2 w; w.x = pk2(o[0], o[1]); w.y = pk2(o[2], o[3]); *(u32x2*)(obf + (size_t)m * DM + 4 * lane + 256 * j) = w; }
            if (of32) *(f32x4*)(of32 + (size_t)m * DM + 4 * lane + 256 * j) = o; } }
}

#define RLX_AGENT __ATOMIC_RELAXED, __HIP_MEMORY_SCOPE_AGENT
#define XB_TMO      128
#define XB_XCNT(j)  (256  + 64 * (j))
#define XB_XSUB(j)  (1280 + 64 * (j))
#define XB_XGEN(j)  (2304 + 64 * (j))
#define XB_TOP      3328
#define XB_TOPGEN   3392
#define XCD_BAR_WORDS 3456
#define XB_SPIN_CAP (1u << 18)

__device__ __forceinline__ unsigned xb_ld(unsigned* p)              { return __hip_atomic_load(p, __ATOMIC_RELAXED, __HIP_MEMORY_SCOPE_AGENT); }
__device__ __forceinline__ unsigned xb_add(unsigned* p, unsigned v) { return __hip_atomic_fetch_add(p, v, __ATOMIC_RELAXED, __HIP_MEMORY_SCOPE_AGENT); }
__device__ __forceinline__ unsigned xb_xcc_id() { return (unsigned)__builtin_amdgcn_s_getreg((3 << 11) | 20) & 0xFu; }
#define XB_SPIN(cond, bar) do { unsigned _sp = 0; while (cond) { __builtin_amdgcn_s_sleep(1); \
    if ((++_sp & 255u) == 0u) { if (xb_ld(&(bar)[XB_TMO])) break; if (_sp > XB_SPIN_CAP) { atomicAdd(&(bar)[XB_TMO], 1u); break; } } } } while (0)

struct XcdBarrier {
    unsigned* bar; unsigned x;
    volatile LAS unsigned* st;
};

__device__ __forceinline__ XcdBarrier xcd_barrier_post(unsigned* bar, volatile LAS unsigned* st) {
    XcdBarrier b; b.bar = bar; b.x = xb_xcc_id(); b.st = st;
    if (threadIdx.x == 0) (void)xb_add(&bar[XB_XCNT(b.x)], 1u);
    return b;
}
__device__ __forceinline__ void xcd_barrier_complete(unsigned* bar, unsigned x, unsigned& nloc, unsigned& nx) {
    const unsigned G = gridDim.x * gridDim.y * gridDim.z;
    unsigned sum, cnt, mine, sp = 0u;
    for (;;) {
        sum = 0u; cnt = 0u; mine = 0u;
#pragma unroll
        for (unsigned j = 0; j < 16; ++j) { const unsigned c = xb_ld(&bar[XB_XCNT(j)]); sum += c; cnt += (c > 0u) ? 1u : 0u; mine = (j == x) ? c : mine; }
        if (sum == G) break;
        __builtin_amdgcn_s_sleep(1);
        if ((++sp & 255u) == 0u) { if (xb_ld(&bar[XB_TMO])) break; if (sp > XB_SPIN_CAP) { atomicAdd(&bar[XB_TMO], 1u); break; } }
    }
    nloc = mine > 0u ? mine : 1u; nx = cnt > 0u ? cnt : 1u;
}

__device__ __forceinline__ void xcd_barrier(const XcdBarrier& b) {
    asm volatile("s_waitcnt vmcnt(0)" ::: "memory");
    __syncthreads();
    if (threadIdx.x == 0) {
        unsigned* bar = b.bar;
        __builtin_amdgcn_s_waitcnt(0);
        unsigned nloc = b.st[0], nx = b.st[1];
        if (nloc == 0u) { xcd_barrier_complete(bar, b.x, nloc, nx); b.st[0] = nloc; b.st[1] = nx; }
        const unsigned old = xb_add(&bar[XB_XSUB(b.x)], 1u);
        const unsigned gen = old / nloc;
        if (old + 1u == (gen + 1u) * nloc) {
            __builtin_amdgcn_fence(__ATOMIC_RELEASE, "agent");
            asm volatile("s_waitcnt vmcnt(0)" ::: "memory");
            const unsigned og = xb_add(&bar[XB_TOP], 1u);
            const unsigned tg = og / nx;
            if (og + 1u == (tg + 1u) * nx) xb_add(&bar[XB_TOPGEN], 1u);
            else XB_SPIN(xb_ld(&bar[XB_TOPGEN]) == tg, bar);
            __builtin_amdgcn_fence(__ATOMIC_ACQUIRE, "agent");
            xb_add(&bar[XB_XGEN(b.x)], 1u);
            asm volatile("s_waitcnt vmcnt(0)" ::: "memory");
        } else {
            XB_SPIN(xb_ld(&bar[XB_XGEN(b.x)]) == gen, bar);
            __builtin_amdgcn_fence(__ATOMIC_ACQUIRE, "agent");
            asm volatile("s_waitcnt vmcnt(0)" ::: "memory");
        }
    }
    __syncthreads();
}
#ifndef PHMASK
#define PHMASK 0x3ff
#endif
#define PH(n) ((PHMASK >> (n)) & 1)
#ifndef DBLMASK
#define DBLMASK 0
#endif
#define REP(n) for (int rep_ = 0; rep_ < 1 + ((DBLMASK >> (n)) & 1); ++rep_)
__global__ void __launch_bounds__(NTHREADS, 2) hymba_fwd(Params P) {
    extern __shared__ __attribute__((aligned(16))) unsigned char lds_raw[];
    LAS unsigned char* lds = (LAS unsigned char*)lds_raw;
    cg::grid_group grid = cg::this_grid();
    const int tid = threadIdx.x, lane = tid & 63, wave = __builtin_amdgcn_readfirstlane(tid >> 6), G = gridDim.x;
    unsigned char* ws = P.ws;
    if (G == 0x7fffffff) grid.sync();
    volatile LAS unsigned* bst = (volatile LAS unsigned*)(lds + 131072);
    if (tid < 2) bst[tid] = 0u;
    __syncthreads();
    const XcdBarrier xbar = xcd_barrier_post((unsigned*)ws, bst);
#define GSYNC() xcd_barrier(xbar)
    bf16* WIN = (bf16*)(ws + WS_WIN); bf16* WOUT = (bf16*)(ws + WS_WOUT); bf16* WGU = (bf16*)(ws + WS_WGU); bf16* WDN = (bf16*)(ws + WS_WDN);
    bf16* XB = (bf16*)(ws + WS_XB); bf16* PROJ = (bf16*)(ws + WS_PROJ); bf16* MIXED = (bf16*)(ws + WS_MIXED); bf16* HB = (bf16*)(ws + WS_H); bf16* ACT = (bf16*)(ws + WS_ACT);

#if PH(0)
    REP(0) p0_prologue(P, lds, tid, lane, wave, G);
#endif
    GSYNC();
#if PH(1)
    REP(1) {
        pg8::Gemm g{XB, WIN, M, NPROJ, DM, DM}; pg8::StaticOrder S; S.init(M, NPROJ, G, (int)blockIdx.x);
        pg8::EpiBf16<0> E{PROJ, NPROJ, nullptr, 0, 0, 1.f};
        pg8::gemm_phase<pg8::EpiBf16<0>, pg8::StaticOrder, true, true>(lds, g, S, E);
    }
    GSYNC();
#endif
#if PH(2)
    REP(2) for (int u = blockIdx.x; u < 4 * NCH; u += G) {
#if !defined(NO_ATTN)
        if (u < 2 * NCH) attn_unit(P, lds, u >> 1, u & 1, tid, lane, wave);
#endif
#if !defined(NO_BST)
        if (u >= 2 * NCH) { const int v = u - 2 * NCH; bstate_unit(P, lds, v >> 1, v & 1, tid, lane, wave); }
#endif
    }
    GSYNC();
#endif
#if PH(3)
    REP(3) p3_scan(P, tid, G);
#ifdef XSYNC
    for (int xs_ = 0; xs_ < XSYNC; ++xs_) GSYNC();
#endif
#endif
    GSYNC();
#if PH(4)
    REP(4) for (int u = blockIdx.x; u < 2 * NCH; u += G) ssd_unit(P, lds, u >> 1, u & 1, tid, lane, wave);
    GSYNC();
#endif
#if PH(5)
    REP(5) {
        pg8::Gemm g{MIXED, WOUT, M, DM, DM, DM}; pg8::StaticOrder S; S.init(MP, DM, G, (int)blockIdx.x);
        pg8::EpiResBf16 E{P.x_prompt, nullptr, (bf16*)(ws + WS_PRE1), DM, ALPHA};
        pg8::gemm_phase<pg8::EpiResBf16, pg8::StaticOrder, true, true>(lds, g, S, E);
        pg8::Gemm gt{MIXED, WOUT, M, DM, DM, 256}; pg8::TailOrder T{MP / 256, 32, 4, 256, G, (int)((blockIdx.x + 128) % G)};
        pg8::EpiPartF32 Et{(float*)(ws + WS_PART), DM, MP, MS, 256};
        pg8::gemm_phase<pg8::EpiPartF32, pg8::TailOrder, false, true>(lds, gt, T, Et);
    }
    GSYNC();
#endif
#if PH(6)
    REP(6) ln_rows((const bf16*)(ws + WS_PRE1), P.ln1_g, P.ln1_b, HB, nullptr, (const float*)(ws + WS_PART), 4, P.x_sample, nullptr, lane, wave, G);
    GSYNC();
#endif
#if PH(7)
    REP(7) {
        pg8::Gemm g{HB, WGU, M, NGU, DM, DM}; pg8::StaticOrder S; S.init(M, NGU, G, (int)blockIdx.x);
        pg8::EpiSwiglu E{ACT, DFF};
        pg8::gemm_phase<pg8::EpiSwiglu, pg8::StaticOrder, true, true>(lds, g, S, E);
    }
    GSYNC();
#endif
#if PH(8)
    REP(8) {
        pg8::Gemm g{ACT, WDN, M, DM, DFF, DFF}; pg8::StaticOrder S; S.init(MP, DM, G, (int)blockIdx.x);
        pg8::EpiResBf16 E{nullptr, HB, (bf16*)(ws + WS_PRE2), DM, ALPHA};
        pg8::gemm_phase<pg8::EpiResBf16, pg8::StaticOrder, true, true>(lds, g, S, E);
        pg8::Gemm gt{ACT, WDN, M, DM, DFF, 256}; pg8::TailOrder T{MP / 256, 88, 11, 256, G, (int)((blockIdx.x + 128) % G)};
        pg8::EpiPartF32 Et{(float*)(ws + WS_PART), DM, MP, MS, 256};
        pg8::gemm_phase<pg8::EpiPartF32, pg8::TailOrder, false, true>(lds, gt, T, Et);
    }
    GSYNC();
#endif
#if PH(9)
    ln_rows((const bf16*)(ws + WS_PRE2), P.ln2_g, P.ln2_b, nullptr, P.out + O_Y, (const float*)(ws + WS_PART), 11, nullptr, HB, lane, wave, G);
#endif
}

extern "C" void kernel_launch(void* const* d_in, const int* in_sizes, int n_in, void* d_out, int out_size, void* d_ws, size_t ws_size, hipStream_t stream) {
    static int grid = 0;
    if (grid == 0) {
        if (n_in != 22 || (size_t)out_size != O_END || ws_size < WS_END) { fprintf(stderr, "kernel_launch: unexpected shapes: n_in %d out %d ws %zu (need %zu)\n", n_in, out_size, ws_size, (size_t)WS_END); grid = -1; return; }
        int dev = 0, cus = 0, per_cu = 0;
        hipGetDevice(&dev); hipDeviceGetAttribute(&cus, hipDeviceAttributeMultiprocessorCount, dev);
        hipFuncSetAttribute((const void*)hymba_fwd, hipFuncAttributeMaxDynamicSharedMemorySize, LDS_BYTES);
        hipOccupancyMaxActiveBlocksPerMultiprocessor(&per_cu, (const void*)hymba_fwd, NTHREADS, LDS_BYTES);
        if (per_cu < 1) { fprintf(stderr, "kernel_launch: occupancy query says %d blocks/CU\n", per_cu); per_cu = 1; }
        grid = cus * per_cu;
    }
    if (grid < 0) return;
    Params p{};
    const float** pp = (const float**)&p;
    for (int i = 0; i < 22; ++i) pp[i] = (const float*)d_in[i];
    p.out = (float*)d_out; p.ws = (unsigned char*)d_ws;
    if (hipMemsetAsync(d_ws, 0, 16384, stream) != hipSuccess) { fprintf(stderr, "memset failed\n"); return; }
    void* args[] = {&p};
    hipError_t e = hipLaunchCooperativeKernel((const void*)hymba_fwd, dim3(grid), dim3(NTHREADS), args, LDS_BYTES, stream);
    if (e != hipSuccess) fprintf(stderr, "cooperative launch failed: %s (grid %d)\n", hipGetErrorString(e), grid);
}
```

```cpp
#include <hip/hip_runtime.h>
#include <hip/hip_cooperative_groups.h>
#include <cstdio>
#include <cstdint>
namespace cg = cooperative_groups;
namespace pg8 {
#define PG8_LAS __attribute__((address_space(3)))
typedef unsigned short bf16_t;
typedef short bf16x8 __attribute__((ext_vector_type(8)));
typedef float f32x4 __attribute__((ext_vector_type(4)));
typedef unsigned u32x4 __attribute__((ext_vector_type(4)));
constexpr int BM = 256, BK = 64, HALF = 128, HTB = HALF * BK * 2  , STAGE_BYTES = 8 * HTB, NXCD = 8, WGM = 8;

__host__ __device__ __forceinline__ int lds_byte(int r, int c) { const int st = (r >> 4) * 2 + (c >> 5), rr = r & 15, cc = c & 31, ob = rr * 64 + cc * 2; return st * 1024 + (ob ^ (((ob >> 9) & 1) << 5)); }
__host__ __device__ __forceinline__ void stage_rc(int b, int& R, int& C) { const int st = b / 1024, sb = b % 1024, swz = sb ^ (((sb >> 9) & 1) << 5); R = (st >> 1) * 16 + swz / 64; C = (st & 1) * 32 + (swz % 64) / 2; }
__host__ __device__ __forceinline__ int perm32(int rho) { const int n = rho >> 4, i = rho & 15; return 8 * (i >> 2) + 4 * n + (i & 3); }

struct Unit { int pm, pn, k0; };
struct Gemm { const bf16_t* A; const bf16_t* Bt; int M, N, K, KL; };

struct StaticOrder {
    int nM, nN, nwg, G, c;
    __host__ __device__ void init(int M, int N, int G_, int c_) { nM = M / BM; nN = N / BM; nwg = nM * nN; G = G_; c = c_; }
    __host__ __device__ bool next(int i, Unit& u) const {
        const long L = (long)i * G + c; if (L >= nwg) return false;
        int wgid = (int)L; { const int q = nwg / NXCD, r = nwg % NXCD, xcd = wgid % NXCD, off = wgid / NXCD; wgid = (xcd < r ? xcd * (q + 1) : r * (q + 1) + (xcd - r) * q) + off; }
        const int nig = WGM * nN, gid = wgid / nig, fm = gid * WGM, gsz = (nM - fm) < WGM ? (nM - fm) : WGM;
        u.pm = fm + ((wgid % nig) % gsz); u.pn = (wgid % nig) / gsz; u.k0 = 0; return true;
    }
    __device__ __forceinline__ void a_ready(const Unit&) const {}
    __device__ __forceinline__ void done(const Unit&) const {}
};

struct TailOrder {
    int pm0, nitems, S, KL, G, c;
    __device__ __forceinline__ bool next(int i, Unit& u) const { const int L = i * G + c; if (L >= nitems) return false; const int un = L / S, ks = L - un * S; u.pm = pm0 + (un >> 2); u.pn = un & 3; u.k0 = ks * KL; return true; }
    __device__ __forceinline__ void a_ready(const Unit&) const {}
    __device__ __forceinline__ void done(const Unit&) const {}
};

__device__ __forceinline__ unsigned cvt_pk_bf16(float lo, float hi) { unsigned r; asm volatile("v_cvt_pk_bf16_f32 %0, %1, %2" : "=v"(r) : "v"(lo), "v"(hi)); return r; }
typedef float f32x2 __attribute__((ext_vector_type(2)));
__device__ __forceinline__ f32x2 gelu_pk(f32x2 v) {
    const f32x2 av = __builtin_elementwise_abs(v), d = av * 0.2316418882f + 1.0f;
    f32x2 t; t.x = __builtin_amdgcn_rcpf(d.x); t.y = __builtin_amdgcn_rcpf(d.y);
    f32x2 q = t * 0.5307027145f + (-0.7265760135f); q = q * t + 0.7107068705f; q = q * t + (-0.142248368f); q = q * t + 0.127414796f; q = q * t;
    const f32x2 s = (v * v) * (-0.72134752044f);
    f32x2 e; e.x = __builtin_amdgcn_exp2f(s.x); e.y = __builtin_amdgcn_exp2f(s.y);
    const f32x2 m = v * (q * e), r = v - m;
    f32x2 o; o.x = v.x < 0.f ? m.x : r.x; o.y = v.y < 0.f ? m.y : r.y; return o;
}

template <int ACT  > struct EpiBf16 {
    static constexpr bool PERM = true, AFTER_DRAIN = false; static_assert(ACT == 0 || ACT == 1, "EpiBf16: ACT is 0 (none) or 1 (gelu_pk)");
    bf16_t* O; int ldc; const float* bias; int split_cols; size_t split_stride; float scale0;
    __device__ __forceinline__ void operator()(const f32x4 (&acc)[2][2][4][2], const Unit& u, int wr, int wc, int fr, int fq) const {
        const int row0 = u.pm * BM + wr * 64 + fr; int colt = u.pn * BM; bf16_t* base = O;
        float sc = 1.f; if (split_cols) { const int t = colt / split_cols; base += (size_t)t * split_stride; colt -= t * split_cols; if (t == 0) sc = scale0; }
        const int col0 = colt + wc * 32 + 8 * fq, bcol0 = u.pn * BM + wc * 32 + 8 * fq;
        f32x4 bv[2][2];
#pragma unroll
        for (int bj = 0; bj < 2; ++bj)
#pragma unroll
            for (int n = 0; n < 2; ++n) bv[bj][n] = bias ? *(const f32x4*)(bias + bcol0 + bj * HALF + 4 * n) : (f32x4){0.f, 0.f, 0.f, 0.f};
#pragma unroll
        for (int ai = 0; ai < 2; ++ai)
#pragma unroll
            for (int m = 0; m < 4; ++m) { bf16_t* rowp = base + (size_t)(row0 + ai * HALF + m * 16) * ldc + col0;
#pragma unroll
                for (int bj = 0; bj < 2; ++bj) { f32x4 v0 = acc[ai][bj][m][0] + bv[bj][0], v1 = acc[ai][bj][m][1] + bv[bj][1];
                    if (ACT == 1) { f32x2 a = gelu_pk((f32x2){v0[0], v0[1]}), b = gelu_pk((f32x2){v0[2], v0[3]}), c = gelu_pk((f32x2){v1[0], v1[1]}), d = gelu_pk((f32x2){v1[2], v1[3]});
                        v0 = (f32x4){a.x, a.y, b.x, b.y}; v1 = (f32x4){c.x, c.y, d.x, d.y}; }
                    v0 = v0 * sc; v1 = v1 * sc; u32x4 w; w.x = cvt_pk_bf16(v0[0], v0[1]); w.y = cvt_pk_bf16(v0[2], v0[3]); w.z = cvt_pk_bf16(v1[0], v1[1]); w.w = cvt_pk_bf16(v1[2], v1[3]);
                    *(u32x4*)(rowp + bj * HALF) = w; } }
    }
};
template <class Epi, class Sched, bool ALIGN_EPI = false, bool SP2 = false>
__device__ __forceinline__ void gemm_phase(PG8_LAS unsigned char* lds, const Gemm g, const Sched& S, const Epi& E) {
    int tid_o = threadIdx.x; asm volatile("" : "+v"(tid_o));
    const int tid = tid_o, wid = __builtin_amdgcn_readfirstlane(tid >> 6), lane = tid & 63, wr = wid >> 2, wc = wid & 3, fr = lane & 15, fq = lane >> 4;
    const int K = g.K, nt = g.KL / BK;
    unsigned voffA[2], voffB[2];
#pragma unroll
    for (int i = 0; i < 2; ++i) { int R, C; stage_rc(tid * 16 + i * 8192, R, C); const int Rb = Epi::PERM ? ((R & ~31) + perm32(R & 31)) : R;
        voffA[i] = (unsigned)(R * K + C) * 2u; voffB[i] = (unsigned)(Rb * K + C) * 2u; }
    const size_t kstep = (size_t)(BK * 2);
    const size_t hstep = (size_t)HALF * K * 2;
    const size_t tstep = 2 * hstep;
    const unsigned ldsw = (unsigned)wid * 1024u;
    const int aoff = lds_byte(wr * 64 + fr, fq * 8), boff = lds_byte(wc * 32 + fr, fq * 8);
#define PG8_SA(b, h) (((b) * 2 + (h)) * HTB)
#define PG8_SB(b, h) ((4 + (b) * 2 + (h)) * HTB)
#define PG8_STAGE(bufoff, gbase, voff) do { _Pragma("unroll") for (int _i = 0; _i < 2; ++_i) \
        __builtin_amdgcn_global_load_lds((const unsigned*)((const char*)(gbase) + (voff)[_i]), (PG8_LAS unsigned*)(lds + (bufoff) + ldsw + _i * 8192), 16, 0, 0); } while (0)
#define PG8_LDA(dst, b, h) do { _Pragma("unroll") for (int m = 0; m < 4; ++m) _Pragma("unroll") for (int k = 0; k < 2; ++k) dst[m][k] = *(const PG8_LAS bf16x8*)(lds + PG8_SA(b, h) + aoff + m * 2048 + k * 1024); } while (0)
#define PG8_LDB(dst, b, h) do { _Pragma("unroll") for (int n = 0; n < 2; ++n) _Pragma("unroll") for (int k = 0; k < 2; ++k) dst[n][k] = *(const PG8_LAS bf16x8*)(lds + PG8_SB(b, h) + boff + n * 2048 + k * 1024); } while (0)
#define PG8_MMA(ai, bj, At, Bt) do { __builtin_amdgcn_s_setprio(1); _Pragma("unroll") for (int m = 0; m < 4; ++m) _Pragma("unroll") for (int n = 0; n < 2; ++n) _Pragma("unroll") for (int k = 0; k < 2; ++k) \
        acc[ai][bj][m][n] = __builtin_amdgcn_mfma_f32_16x16x32_bf16(Bt[n][k], At[m][k], acc[ai][bj][m][n], 0, 0, 0); __builtin_amdgcn_s_setprio(0); } while (0)
#define PG8_WAIT_V(n) asm volatile("s_waitcnt vmcnt(" #n ")" ::: "memory")
#define PG8_WAIT_L(n) asm volatile("s_waitcnt lgkmcnt(" #n ")" ::: "memory")
#define PG8_BAR __builtin_amdgcn_s_barrier()
#define PG8_SCHED __builtin_amdgcn_sched_barrier(0)
    Unit cur, nxt; int ui = 0;
    if (!S.next(0, cur)) return;
    f32x4 acc[2][2][4][2];
#pragma unroll
    for (int a = 0; a < 2; ++a)
#pragma unroll
        for (int b = 0; b < 2; ++b)
#pragma unroll
            for (int m = 0; m < 4; ++m)
#pragma unroll
                for (int n = 0; n < 2; ++n) acc[a][b][m][n] = (f32x4){0.f, 0.f, 0.f, 0.f};
    bf16x8 At[4][2], B0[2][2], B1[2][2];
    const char* cA = (const char*)g.A + (size_t)cur.pm * tstep + (size_t)cur.k0 * 2; const char* cB = (const char*)g.Bt + (size_t)cur.pn * tstep + (size_t)cur.k0 * 2;
    S.a_ready(cur);
    if constexpr (SP2) {
        PG8_STAGE(PG8_SB(0, 0), cB, voffB); PG8_STAGE(PG8_SB(0, 1), cB + hstep, voffB); PG8_STAGE(PG8_SA(0, 0), cA, voffA); PG8_STAGE(PG8_SA(0, 1), cA + hstep, voffA);
        if (wr == 1) PG8_BAR;
        PG8_WAIT_V(2); PG8_BAR;
        PG8_STAGE(PG8_SB(1, 0), cB + kstep, voffB); PG8_STAGE(PG8_SA(1, 0), cA + kstep, voffA); PG8_STAGE(PG8_SB(1, 1), cB + hstep + kstep, voffB);
        PG8_WAIT_V(6); PG8_BAR;
    } else {
        PG8_STAGE(PG8_SB(0, 0), cB, voffB); PG8_STAGE(PG8_SA(0, 0), cA, voffA); PG8_STAGE(PG8_SB(0, 1), cB + hstep, voffB); PG8_STAGE(PG8_SA(0, 1), cA + hstep, voffA);
        if (wr == 1) PG8_BAR;
        PG8_WAIT_V(4); PG8_BAR;
        PG8_STAGE(PG8_SB(1, 0), cB + kstep, voffB); PG8_STAGE(PG8_SA(1, 0), cA + kstep, voffA); PG8_STAGE(PG8_SB(1, 1), cB + hstep + kstep, voffB);
        PG8_WAIT_V(6); PG8_BAR;
    }
    for (;;) {
        const bool has_next = S.next(ui + 1, nxt);
        const char* nA = has_next ? (const char*)g.A + (size_t)nxt.pm * tstep + (size_t)nxt.k0 * 2 : cA; const char* nB = has_next ? (const char*)g.Bt + (size_t)nxt.pn * tstep + (size_t)nxt.k0 * 2 : cB;
        for (int t = 0; t < nt; t += 2) {
            const bool last = (t == nt - 2);
            const char* a1 = cA + (size_t)(t + 1) * kstep;
            const char* a2 = last ? nA : cA + (size_t)(t + 2) * kstep; const char* b2 = last ? nB : cB + (size_t)(t + 2) * kstep;
            const char* a3 = a2 + kstep; const char* b3 = b2 + kstep;
            if (last && has_next) S.a_ready(nxt);
            if constexpr (SP2) {
            PG8_LDB(B0, 0, 0); PG8_LDB(B1, 0, 1); PG8_SCHED; PG8_LDA(At, 0, 0); PG8_STAGE(PG8_SA(1, 1), a1 + hstep, voffA);
            PG8_WAIT_V(8); PG8_WAIT_L(0); PG8_BAR; PG8_MMA(0, 0, At, B0); PG8_MMA(0, 1, At, B1); PG8_BAR; PG8_SCHED;
            PG8_LDA(At, 0, 1); PG8_STAGE(PG8_SB(0, 0), b2, voffB); PG8_STAGE(PG8_SB(0, 1), b2 + hstep, voffB); PG8_STAGE(PG8_SA(0, 0), a2, voffA);
            PG8_WAIT_V(8); PG8_WAIT_L(0); PG8_BAR; PG8_MMA(1, 0, At, B0); PG8_MMA(1, 1, At, B1); PG8_BAR; PG8_SCHED;
            PG8_LDB(B0, 1, 0); PG8_LDB(B1, 1, 1); PG8_SCHED; PG8_LDA(At, 1, 0); PG8_STAGE(PG8_SA(0, 1), a2 + hstep, voffA);
            PG8_WAIT_V(8); PG8_WAIT_L(0); PG8_BAR; PG8_MMA(0, 0, At, B0); PG8_MMA(0, 1, At, B1); PG8_BAR; PG8_SCHED;
            PG8_LDA(At, 1, 1); PG8_STAGE(PG8_SB(1, 0), b3, voffB); PG8_STAGE(PG8_SB(1, 1), b3 + hstep, voffB); PG8_STAGE(PG8_SA(1, 0), a3, voffA);
            PG8_WAIT_V(8); PG8_WAIT_L(0); PG8_BAR; PG8_MMA(1, 0, At, B0); PG8_MMA(1, 1, At, B1); PG8_BAR; PG8_SCHED;
            } else {
            PG8_LDB(B0, 0, 0); PG8_SCHED; PG8_LDA(At, 0, 0); PG8_STAGE(PG8_SA(1, 1), a1 + hstep, voffA);
            PG8_WAIT_L(8); PG8_BAR; PG8_WAIT_L(0); PG8_MMA(0, 0, At, B0); PG8_BAR; PG8_SCHED;
            PG8_LDB(B1, 0, 1); PG8_STAGE(PG8_SB(0, 0), b2, voffB);
            PG8_BAR; PG8_WAIT_L(0); PG8_MMA(0, 1, At, B1); PG8_BAR;
            PG8_LDA(At, 0, 1); PG8_STAGE(PG8_SA(0, 0), a2, voffA);
            PG8_BAR; PG8_WAIT_L(0); PG8_MMA(1, 0, At, B0); PG8_BAR; PG8_SCHED;
            PG8_STAGE(PG8_SB(0, 1), b2 + hstep, voffB);
            PG8_WAIT_V(6); PG8_BAR; PG8_MMA(1, 1, At, B1); PG8_BAR;
            PG8_LDB(B0, 1, 0); PG8_SCHED; PG8_LDA(At, 1, 0); PG8_STAGE(PG8_SA(0, 1), a2 + hstep, voffA);
            PG8_WAIT_L(8); PG8_BAR; PG8_WAIT_L(0); PG8_MMA(0, 0, At, B0); PG8_BAR; PG8_SCHED;
            PG8_LDB(B1, 1, 1); PG8_STAGE(PG8_SB(1, 0), b3, voffB);
            PG8_BAR; PG8_WAIT_L(0); PG8_MMA(0, 1, At, B1); PG8_BAR;
            PG8_LDA(At, 1, 1); PG8_STAGE(PG8_SA(1, 0), a3, voffA);
            PG8_BAR; PG8_WAIT_L(0); PG8_MMA(1, 0, At, B0); PG8_BAR; PG8_SCHED;
            PG8_STAGE(PG8_SB(1, 1), b3 + hstep, voffB);
            PG8_WAIT_V(6); PG8_BAR; PG8_MMA(1, 1, At, B1); PG8_BAR;
            }
        }
        if constexpr (ALIGN_EPI) { if (wr == 0) PG8_BAR; }
        if constexpr (!Epi::AFTER_DRAIN) { E(acc, cur, wr, wc, fr, fq); S.done(cur); }
        if (!has_next) break;
#pragma unroll
        for (int a = 0; a < 2; ++a)
#pragma unroll
            for (int b = 0; b < 2; ++b)
#pragma unroll
                for (int m = 0; m < 4; ++m)
#pragma unroll
                    for (int n = 0; n < 2; ++n) acc[a][b][m][n] = (f32x4){0.f, 0.f, 0.f, 0.f};
        cur = nxt; cA = nA; cB = nB; ++ui;
        if constexpr (ALIGN_EPI) { if (wr == 1) PG8_BAR; }
    }
    PG8_WAIT_V(0);
    if constexpr (!ALIGN_EPI) { if (wr == 0) PG8_BAR; }
    PG8_BAR;
    if constexpr (Epi::AFTER_DRAIN) { E.fused(acc, cur, wr, wc, fr, fq, lds, wid, lane); S.done(cur); }
#undef PG8_SA
#undef PG8_SB
#undef PG8_STAGE
#undef PG8_LDA
#undef PG8_LDB
#undef PG8_MMA
#undef PG8_WAIT_V
#undef PG8_WAIT_L
#undef PG8_BAR
#undef PG8_SCHED
}
}
namespace pg8 {
struct EpiResF32 {
    static constexpr bool PERM = false, AFTER_DRAIN = false;
    const float* xp; const float* xs; int split_pm; float* out; int ldc; float alpha;
    __device__ __forceinline__ void operator()(const f32x4 (&acc)[2][2][4][2], const Unit& u, int wr, int wc, int fr, int fq) const {
        const int col0 = u.pn * BM + wc * 32 + 4 * fq;
        const float* bp = (u.pm < split_pm) ? xp + (size_t)u.pm * BM * ldc : xs + (size_t)(u.pm - split_pm) * BM * ldc;
        float* op = out + (size_t)u.pm * BM * ldc;
#pragma unroll
        for (int ai = 0; ai < 2; ++ai)
#pragma unroll
            for (int m = 0; m < 4; ++m) { const size_t off = (size_t)(ai * HALF + wr * 64 + m * 16 + fr) * ldc + col0;
#pragma unroll
                for (int bj = 0; bj < 2; ++bj)
#pragma unroll
                    for (int n = 0; n < 2; ++n) { const f32x4 bs = *(const f32x4*)(bp + off + bj * HALF + n * 16); const f32x4 o = bs * alpha + acc[ai][bj][m][n]; *(f32x4*)(op + off + bj * HALF + n * 16) = o; }
                if (m & 1) asm volatile("" ::: "memory"); }
    }
};
struct EpiResBf16In {
    static constexpr bool PERM = false, AFTER_DRAIN = false;
    const bf16_t* h; float* out; int ldc; float alpha;
    __device__ __forceinline__ void operator()(const f32x4 (&acc)[2][2][4][2], const Unit& u, int wr, int wc, int fr, int fq) const {
        typedef unsigned u32x2v __attribute__((ext_vector_type(2)));
        const int col0 = u.pn * BM + wc * 32 + 4 * fq;
#pragma unroll
        for (int ai = 0; ai < 2; ++ai)
#pragma unroll
            for (int m = 0; m < 4; ++m) { const size_t off = (size_t)(u.pm * BM + ai * HALF + wr * 64 + m * 16 + fr) * ldc + col0;
#pragma unroll
                for (int bj = 0; bj < 2; ++bj)
#pragma unroll
                    for (int n = 0; n < 2; ++n) { const u32x2v hb = *(const u32x2v*)(h + off + bj * HALF + n * 16);
                        f32x4 bs; bs[0] = __uint_as_float(hb.x << 16); bs[1] = __uint_as_float(hb.x & 0xffff0000u); bs[2] = __uint_as_float(hb.y << 16); bs[3] = __uint_as_float(hb.y & 0xffff0000u);
                        const f32x4 o = bs * alpha + acc[ai][bj][m][n]; *(f32x4*)(out + off + bj * HALF + n * 16) = o; }
                if (m & 1) asm volatile("" ::: "memory"); }
    }
};
struct EpiPartF32 {
    static constexpr bool PERM = false, AFTER_DRAIN = false;
    float* part; int ldc, row0, rows, KL;
    __device__ __forceinline__ void operator()(const f32x4 (&acc)[2][2][4][2], const Unit& u, int wr, int wc, int fr, int fq) const {
        const int col0 = u.pn * BM + wc * 32 + 4 * fq; float* pb = part + (size_t)(u.k0 / KL) * rows * ldc;
#pragma unroll
        for (int ai = 0; ai < 2; ++ai)
#pragma unroll
            for (int m = 0; m < 4; ++m) { float* op = pb + (size_t)(u.pm * BM - row0 + ai * HALF + wr * 64 + m * 16 + fr) * ldc + col0;
#pragma unroll
                for (int bj = 0; bj < 2; ++bj)
#pragma unroll
                    for (int n = 0; n < 2; ++n) *(f32x4*)(op + bj * HALF + n * 16) = acc[ai][bj][m][n]; }
    }
};
struct EpiResBf16 {
    static constexpr bool PERM = true, AFTER_DRAIN = false;
    const float* xp; const bf16_t* hb; bf16_t* out; int ldc; float alpha;
    __device__ __forceinline__ void operator()(const f32x4 (&acc)[2][2][4][2], const Unit& u, int wr, int wc, int fr, int fq) const {
        const int col0 = u.pn * BM + wc * 32 + 8 * fq;
#pragma unroll
        for (int ai = 0; ai < 2; ++ai)
#pragma unroll
            for (int m = 0; m < 4; ++m) { const size_t off = (size_t)(u.pm * BM + ai * HALF + wr * 64 + m * 16 + fr) * ldc + col0;
#pragma unroll
                for (int bj = 0; bj < 2; ++bj) { f32x4 b0, b1;
                    if (xp) { b0 = *(const f32x4*)(xp + off + bj * HALF); b1 = *(const f32x4*)(xp + off + bj * HALF + 4); }
                    else { const u32x4 hw = *(const u32x4*)(hb + off + bj * HALF);
                        b0[0] = __uint_as_float(hw.x << 16); b0[1] = __uint_as_float(hw.x & 0xffff0000u); b0[2] = __uint_as_float(hw.y << 16); b0[3] = __uint_as_float(hw.y & 0xffff0000u);
                        b1[0] = __uint_as_float(hw.z << 16); b1[1] = __uint_as_float(hw.z & 0xffff0000u); b1[2] = __uint_as_float(hw.w << 16); b1[3] = __uint_as_float(hw.w & 0xffff0000u); }
                    const f32x4 v0 = b0 * alpha + acc[ai][bj][m][0], v1 = b1 * alpha + acc[ai][bj][m][1];
                    u32x4 w; w.x = cvt_pk_bf16(v0[0], v0[1]); w.y = cvt_pk_bf16(v0[2], v0[3]); w.z = cvt_pk_bf16(v1[0], v1[1]); w.w = cvt_pk_bf16(v1[2], v1[3]);
                    *(u32x4*)(out + off + bj * HALF) = w; }
                if (m & 1) asm volatile("" ::: "memory"); }
    }
};
struct EpiSwiglu {
    static constexpr bool PERM = true, AFTER_DRAIN = false;
    bf16_t* O; int ldc;
    __device__ __forceinline__ void operator()(const f32x4 (&acc)[2][2][4][2], const Unit& u, int wr, int wc, int fr, int fq) const {
        const int row0 = u.pm * BM + wr * 64 + fr; const int col0 = u.pn * HALF + wc * 32 + 8 * fq;
#pragma unroll
        for (int ai = 0; ai < 2; ++ai)
#pragma unroll
            for (int m = 0; m < 4; ++m) { bf16_t* rowp = O + (size_t)(row0 + ai * HALF + m * 16) * ldc + col0;
                float v[8];
#pragma unroll
                for (int n = 0; n < 2; ++n)
#pragma unroll
                    for (int e = 0; e < 4; ++e) { const float g = acc[ai][0][m][n][e], up = acc[ai][1][m][n][e]; v[n * 4 + e] = g * __builtin_amdgcn_rcpf(1.0f + __expf(-g)) * up; }
                u32x4 w; w.x = cvt_pk_bf16(v[0], v[1]); w.y = cvt_pk_bf16(v[2], v[3]); w.z = cvt_pk_bf16(v[4], v[5]); w.w = cvt_pk_bf16(v[6], v[7]);
                *(u32x4*)rowp = w; }
    }
};
}
#define LAS __attribute__((address_space(3)))
typedef unsigned short bf16;
typedef short bf16x8 __attribute__((ext_vector_type(8)));
typedef short s16x4 __attribute__((ext_vector_type(4)));
typedef float f32x4 __attribute__((ext_vector_type(4)));
typedef float f32x16 __attribute__((ext_vector_type(16)));
typedef unsigned u32x4 __attribute__((ext_vector_type(4)));
typedef unsigned u32x2 __attribute__((ext_vector_type(2)));

constexpr int NWAVES = 8, NTHREADS = 512;
constexpr int DM = 1024, BATCH = 8, SEQ = 4096, DEC_T = 64;
constexpr int MP = BATCH * SEQ, MS = BATCH * DEC_T, M = MP + MS;
constexpr int NCH_P = MP / 64, NCH = M / 64;
constexpr int IN_COLS = 2312, NPROJ = 2304, DFF = 2816, NGU = 2 * DFF;
constexpr int PC_Z = 0, PC_XS = 512, PC_B = 1024, PC_C = 1280, PC_Q = 1536, PC_K = 2048, PC_V = 2176;
constexpr float LN_EPS = 1e-5f, RMS_EPS = 1e-5f, ALPHA = 1.189207115002721f;
constexpr size_t MiB = 1u << 20;
constexpr size_t WS_WIN = 2 * MiB, WS_WOUT = 7 * MiB, WS_WGU = 9 * MiB, WS_WDN = 20 * MiB, WS_DT = 26 * MiB, WS_CDEC = 28 * MiB;
constexpr size_t WS_XB = 32 * MiB, WS_MIXED = WS_XB, WS_PROJ = 97 * MiB, WS_BSTATE = 244 * MiB, WS_SPREV = 374 * MiB, WS_H = 97 * MiB, WS_ACT = 162 * MiB, WS_PART = 376 * MiB, WS_PRE1 = 244 * MiB, WS_PRE2 = 32 * MiB, WS_END = 439 * MiB;
static_assert(WS_XB + (size_t)M * DM * 2 <= WS_PROJ && WS_PROJ + (size_t)M * NPROJ * 2 <= WS_BSTATE && WS_BSTATE + (size_t)NCH * 65536 * 4 <= WS_SPREV && WS_SPREV + (size_t)NCH * 65536 * 2 <= WS_END, "ws map");
static_assert(WS_H + (size_t)M * DM * 2 <= WS_ACT && WS_ACT + (size_t)M * DFF * 2 <= WS_END, "ws map 2");
constexpr size_t O_Y = 0, O_CONVP = (size_t)M * DM, O_SSMP = O_CONVP + 24576, O_KP = O_SSMP + 524288, O_VP = O_KP + 131072, O_CONVS = O_VP + 131072, O_SSMS = O_CONVS + 24576, O_KS = O_SSMS + 524288, O_VS = O_KS + 131072, O_END = O_VS + 131072;
constexpr int LDS_BYTES = 147456;
constexpr int NATT2 = 780;

struct Params {
    const float *x_prompt, *x_sample, *state_conv, *state_ssm, *cache_k, *cache_v, *w_in, *conv_w, *conv_b, *dt_bias, *a_log, *d_skip, *ssm_norm_w, *attn_sinks,
                *w_out, *ln1_g, *ln1_b, *w_gate, *w_up, *w_down, *ln2_g, *ln2_b;
    float* out; unsigned char* ws;
};

__device__ __forceinline__ float bf2f(unsigned short h) { return __uint_as_float((unsigned)h << 16); }
__device__ __forceinline__ unsigned pk2(float lo, float hi) { return pg8::cvt_pk_bf16(lo, hi); }
__device__ __forceinline__ float wave_sum(float v) {
#pragma unroll
    for (int o = 1; o < 64; o <<= 1) v += __shfl_xor(v, o);
    return v;
}
__device__ __forceinline__ float silu_f(float v) { return v * __builtin_amdgcn_rcpf(1.0f + __expf(-v)); }
__device__ __forceinline__ void unpack8(const u32x4 w, float (&f)[8]) {
    f[0] = __uint_as_float(w.x << 16); f[1] = __uint_as_float(w.x & 0xffff0000u); f[2] = __uint_as_float(w.y << 16); f[3] = __uint_as_float(w.y & 0xffff0000u);
    f[4] = __uint_as_float(w.z << 16); f[5] = __uint_as_float(w.z & 0xffff0000u); f[6] = __uint_as_float(w.w << 16); f[7] = __uint_as_float(w.w & 0xffff0000u);
}

__device__ __forceinline__ void p0_item(const float* W, int ldw, int k0, int nsrc0, bf16* WT, int K, int drow0, LAS float* scr, int lane) {
#pragma unroll 8
    for (int i = 0; i < 32; ++i) { const int kk = 2 * i + (lane >> 5); scr[kk * 33 + (lane & 31)] = W[(size_t)(k0 + kk) * ldw + nsrc0 + (lane & 31)]; }
    asm volatile("s_waitcnt lgkmcnt(0)" ::: "memory");
    const int c = lane & 7;
#pragma unroll
    for (int j = 0; j < 4; ++j) { const int n = (lane >> 3) + 8 * j; const LAS float* s = scr + (8 * c) * 33 + n;
        u32x4 o; o.x = pk2(s[0 * 33], s[1 * 33]); o.y = pk2(s[2 * 33], s[3 * 33]); o.z = pk2(s[4 * 33], s[5 * 33]); o.w = pk2(s[6 * 33], s[7 * 33]);
        *(u32x4*)(WT + (size_t)(drow0 + n) * K + k0 + 8 * c) = o; }
    asm volatile("s_waitcnt lgkmcnt(0)" ::: "memory");
}

__device__ __forceinline__ void p0_prologue(const Params& P, LAS unsigned char* lds, int tid, int lane, int wave, int G) {
    unsigned char* ws = P.ws;
    bf16* WIN = (bf16*)(ws + WS_WIN); bf16* WOUT = (bf16*)(ws + WS_WOUT); bf16* WGU = (bf16*)(ws + WS_WGU); bf16* WDN = (bf16*)(ws + WS_WDN);
    bf16* XB = (bf16*)(ws + WS_XB); float* DT = (float*)(ws + WS_DT);
    LAS float* scr = (LAS float*)(lds + wave * 8448);
    LAS float* wdt = (LAS float*)(lds + 73728);
    for (int i = tid; i < 8192; i += NTHREADS) { const int k = i >> 3, h = i & 7; wdt[h * 1024 + k] = P.w_in[(size_t)k * IN_COLS + 1536 + h]; }
    const int gw = blockIdx.x * NWAVES + wave, NGW = G * NWAVES;
    constexpr int I_IN = 16 * 72, I_OUT = 16 * 32, I_GU = 16 * 176, I_DN = 44 * 32, NITEMS = I_IN + I_OUT + I_GU + I_DN;
    for (int it = gw; it < NITEMS; it += NGW) {
        int r = it;
        if (r < I_IN) { const int kb = r / 72, nb = r % 72, n0 = 32 * nb; p0_item(P.w_in, IN_COLS, 64 * kb, n0 + (n0 >= 1536 ? 8 : 0), WIN, DM, n0, scr, lane); continue; } r -= I_IN;
        if (r < I_OUT) { const int kb = r / 32, nb = r % 32; p0_item(P.w_out, DM, 64 * kb, 32 * nb, WOUT, DM, 32 * nb, scr, lane); continue; } r -= I_OUT;
        if (r < I_GU) { const int kb = r / 176, nb = r % 176, t = nb >> 3, s = (nb >> 2) & 1, i0 = 32 * (nb & 3); p0_item(s ? P.w_up : P.w_gate, DFF, 64 * kb, 128 * t + i0, WGU, DM, 32 * nb, scr, lane); continue; } r -= I_GU;
        { const int kb = r / 32, nb = r % 32; p0_item(P.w_down, DM, 64 * kb, 32 * nb, WDN, DFF, 32 * nb, scr, lane); }
    }
    __syncthreads();
    float bias = 0.f; if (lane < 8) bias = P.dt_bias[lane];
    for (int m = gw; m < M; m += NGW) {
        const float* xrow = (m < MP) ? P.x_prompt + (size_t)m * DM : P.x_sample + (size_t)(m - MP) * DM;
        f32x4 v[4];
#pragma unroll
        for (int j = 0; j < 4; ++j) v[j] = *(const f32x4*)(xrow + 4 * lane + 256 * j);
        unsigned long long* o8 = (unsigned long long*)(XB + (size_t)m * DM) + lane;
#pragma unroll
        for (int j = 0; j < 4; ++j) o8[64 * j] = (unsigned long long)pk2(v[j][0], v[j][1]) | ((unsigned long long)pk2(v[j][2], v[j][3]) << 32);
        float mine = 0.f;
#pragma unroll
        for (int h = 0; h < 8; ++h) { float a = 0.f;
#pragma unroll
            for (int j = 0; j < 4; ++j) { const f32x4 w = *(const LAS f32x4*)(wdt + h * 1024 + 4 * lane + 256 * j); a += v[j][0] * w[0] + v[j][1] * w[1] + v[j][2] * w[2] + v[j][3] * w[3]; }
            a = wave_sum(a); if (lane == h) mine = a; }
        if (lane < 8) { const float xx = mine + bias; DT[(size_t)m * 8 + lane] = (xx > 20.f) ? xx : log1pf(__expf(xx)); }
    }
}

__device__ __forceinline__ void conv8x4(const Params& P, const bf16* PROJ, int cid, int pcol, int cch, int t0, float (&o)[4][8]) {
    const bool sample = cid >= NCH_P; const bool has_prev = (!sample) && ((cid & 63) != 0);
    const size_t m0 = (size_t)cid * 64;
    float xin[7][8];
#pragma unroll
    for (int rr = 0; rr < 7; ++rr) { const int lt = t0 - 3 + rr;
        if (lt >= 0 || has_prev) { const u32x4 w = *(const u32x4*)(PROJ + (size_t)((long)m0 + lt) * NPROJ + pcol); unpack8(w, xin[rr]); }
        else if (sample) { const float* sc = P.state_conv + ((size_t)(cid - NCH_P) * 3 + (lt + 3)) * 1024 + cch; const f32x4 a = *(const f32x4*)sc, b = *(const f32x4*)(sc + 4);
            xin[rr][0] = a[0]; xin[rr][1] = a[1]; xin[rr][2] = a[2]; xin[rr][3] = a[3]; xin[rr][4] = b[0]; xin[rr][5] = b[1]; xin[rr][6] = b[2]; xin[rr][7] = b[3]; }
        else {
#pragma unroll
            for (int e = 0; e < 8; ++e) xin[rr][e] = 0.f; } }
    float cw[4][8], cb[8];
#pragma unroll
    for (int i = 0; i < 4; ++i) { const f32x4 a = *(const f32x4*)(P.conv_w + i * 1024 + cch), b = *(const f32x4*)(P.conv_w + i * 1024 + cch + 4);
        cw[i][0] = a[0]; cw[i][1] = a[1]; cw[i][2] = a[2]; cw[i][3] = a[3]; cw[i][4] = b[0]; cw[i][5] = b[1]; cw[i][6] = b[2]; cw[i][7] = b[3]; }
    { const f32x4 a = *(const f32x4*)(P.conv_b + cch), b = *(const f32x4*)(P.conv_b + cch + 4); cb[0] = a[0]; cb[1] = a[1]; cb[2] = a[2]; cb[3] = a[3]; cb[4] = b[0]; cb[5] = b[1]; cb[6] = b[2]; cb[7] = b[3]; }
#pragma unroll
    for (int tt = 0; tt < 4; ++tt)
#pragma unroll
        for (int e = 0; e < 8; ++e) { float a = cb[e];
#pragma unroll
            for (int i = 0; i < 4; ++i) a += cw[i][e] * xin[tt + i][e];
            o[tt][e] = silu_f(a); }
}

constexpr int KS_STR = 72, VT_STR = 200;
__device__ __forceinline__ void attn_unit(const Params& P, LAS unsigned char* lds, int cid, int kv, int tid, int lane, int wave) {
    asm volatile("" : "+v"(tid), "+v"(lane));
    const bf16* PROJ = (const bf16*)(P.ws + WS_PROJ); bf16* MIXED = (bf16*)(P.ws + WS_MIXED);
    LAS bf16* Ks = (LAS bf16*)lds; LAS bf16* VT = (LAS bf16*)(lds + 192 * KS_STR * 2);
    const bool sample = cid >= NCH_P; const int c = cid & 63; const size_t m0 = (size_t)cid * 64;
    const int r = wave >> 1, th = wave & 1, hq = kv * 4 + r, l31 = lane & 31, hh = lane >> 5; int tq = 32 * th + l31; asm volatile("" : "+v"(tq));
    bf16x8 qf[4]; { const bf16* qp = PROJ + (m0 + tq) * NPROJ + PC_Q + hq * 64 + 8 * hh;
#pragma unroll
        for (int ks = 0; ks < 4; ++ks) qf[ks] = *(const bf16x8*)(qp + 16 * ks); }
    for (int idx = tid; idx < 1536; idx += NTHREADS) { const int j = idx >> 3, ch = idx & 7;
        u32x4 k8 = (u32x4){0u, 0u, 0u, 0u}, v8 = (u32x4){0u, 0u, 0u, 0u};
        if (sample && j < 128) { const size_t o = (((size_t)(cid - NCH_P) * 128 + j) * 2 + kv) * 64 + ch * 8;
            const f32x4 a = *(const f32x4*)(P.cache_k + o), b = *(const f32x4*)(P.cache_k + o + 4), cc = *(const f32x4*)(P.cache_v + o), d = *(const f32x4*)(P.cache_v + o + 4);
            k8.x = pk2(a[0], a[1]); k8.y = pk2(a[2], a[3]); k8.z = pk2(b[0], b[1]); k8.w = pk2(b[2], b[3]);
            v8.x = pk2(cc[0], cc[1]); v8.y = pk2(cc[2], cc[3]); v8.z = pk2(d[0], d[1]); v8.w = pk2(d[2], d[3]); }
        else if (sample || (c * 64 - 128 + j >= 0)) { const bf16* rp = PROJ + (size_t)((long)m0 - 128 + j) * NPROJ + kv * 64 + ch * 8; k8 = *(const u32x4*)(rp + PC_K); v8 = *(const u32x4*)(rp + PC_V); }
        *(LAS u32x4*)(Ks + j * KS_STR + ch * 8) = k8;
        LAS bf16* vp = VT + (ch * 8) * VT_STR + j;
        vp[0 * VT_STR] = (bf16)(v8.x & 0xffff); vp[1 * VT_STR] = (bf16)(v8.x >> 16); vp[2 * VT_STR] = (bf16)(v8.y & 0xffff); vp[3 * VT_STR] = (bf16)(v8.y >> 16);
        vp[4 * VT_STR] = (bf16)(v8.z & 0xffff); vp[5 * VT_STR] = (bf16)(v8.z >> 16); vp[6 * VT_STR] = (bf16)(v8.w & 0xffff); vp[7 * VT_STR] = (bf16)(v8.w >> 16); }
    __syncthreads();
    f32x16 sacc[6];
#pragma unroll
    for (int kt = 0; kt < 6; ++kt) {
#pragma unroll
        for (int i = 0; i < 16; ++i) sacc[kt][i] = 0.f;
#pragma unroll
        for (int ks = 0; ks < 4; ++ks) { const bf16x8 a = *(const LAS bf16x8*)(Ks + (32 * kt + l31) * KS_STR + 16 * ks + 8 * hh); sacc[kt] = __builtin_amdgcn_mfma_f32_32x32x16_bf16(a, qf[ks], sacc[kt], 0, 0, 0); }
        __builtin_amdgcn_sched_barrier(0); }
    const float slope = exp2f(-(float)(hq + 1)), sink = P.attn_sinks[hq];
    float mx = sink;
#pragma unroll
    for (int kt = 0; kt < 6; ++kt) { const bool valid = sample || (2 * c + kt >= 4);
#pragma unroll
        for (int i = 0; i < 16; ++i) { const int key = 32 * kt + (i & 3) + 8 * (i >> 2) + 4 * hh; const float dist = fabsf((float)(128 + tq - key));
            const float s = valid ? (sacc[kt][i] * 0.125f - slope * dist) : -INFINITY; sacc[kt][i] = s; mx = fmaxf(mx, s); }
        __builtin_amdgcn_sched_barrier(0); }
    mx = fmaxf(mx, __shfl_xor(mx, 32));
    float sum = 0.f;
#pragma unroll
    for (int kt = 0; kt < 6; ++kt)
#pragma unroll
        for (int i = 0; i < 16; ++i) { const float p = __expf(sacc[kt][i] - mx); sacc[kt][i] = p; sum += p; }
    sum += __shfl_xor(sum, 32);
    const float inv = 1.0f / (sum + __expf(sink - mx));
    f32x16 oacc[2];
#pragma unroll
    for (int d2 = 0; d2 < 2; ++d2)
#pragma unroll
        for (int i = 0; i < 16; ++i) oacc[d2][i] = 0.f;
#pragma unroll
    for (int kt = 0; kt < 6; ++kt)
#pragma unroll
        for (int s2 = 0; s2 < 2; ++s2) {
            union { u32x4 u; bf16x8 v; } pf;
            pf.u.x = pk2(sacc[kt][8 * s2 + 0], sacc[kt][8 * s2 + 1]); pf.u.y = pk2(sacc[kt][8 * s2 + 2], sacc[kt][8 * s2 + 3]);
            pf.u.z = pk2(sacc[kt][8 * s2 + 4], sacc[kt][8 * s2 + 5]); pf.u.w = pk2(sacc[kt][8 * s2 + 6], sacc[kt][8 * s2 + 7]);
#pragma unroll
            for (int d2 = 0; d2 < 2; ++d2) { const LAS bf16* vp = VT + (32 * d2 + l31) * VT_STR + 32 * kt + 16 * s2 + 4 * hh;
                union { u32x4 u; bf16x8 v; } af; const u32x2 lo = *(const LAS u32x2*)vp, hi = *(const LAS u32x2*)(vp + 8); af.u.x = lo.x; af.u.y = lo.y; af.u.z = hi.x; af.u.w = hi.y;
                oacc[d2] = __builtin_amdgcn_mfma_f32_32x32x16_bf16(af.v, pf.v, oacc[d2], 0, 0, 0); }
            __builtin_amdgcn_sched_barrier(0); }
    bf16* op = MIXED + (m0 + tq) * DM + 512 + hq * 64 + 4 * hh;
#pragma unroll
    for (int d2 = 0; d2 < 2; ++d2)
#pragma unroll
        for (int rg = 0; rg < 4; ++rg) { u32x2 w; w.x = pk2(oacc[d2][4 * rg] * inv, oacc[d2][4 * rg + 1] * inv); w.y = pk2(oacc[d2][4 * rg + 2] * inv, oacc[d2][4 * rg + 3] * inv);
            *(u32x2*)(op + 32 * d2 + 8 * rg) = w; }
    __syncthreads();
}

constexpr int XT_STR = 72, BM_STR = 136, CB_STR = 68;
__device__ __forceinline__ float wave_incl_scan(float v, int lane) {
#pragma unroll
    for (int o = 1; o < 64; o <<= 1) { const float t = __shfl_up(v, o); if (lane >= o) v += t; }
    return v;
}
__device__ __forceinline__ void bstate_unit(const Params& P, LAS unsigned char* lds, int cid, int g, int tid, int lane, int wave) {
    asm volatile("" : "+v"(tid), "+v"(lane));
    const bf16* PROJ = (const bf16*)(P.ws + WS_PROJ); const float* DT = (const float*)(P.ws + WS_DT); float* CDEC = (float*)(P.ws + WS_CDEC); float* BST = (float*)(P.ws + WS_BSTATE);
    LAS bf16* xsT = (LAS bf16*)lds;
    LAS bf16* BmT = (LAS bf16*)(lds + 256 * XT_STR * 2);
    LAS float* wsc = (LAS float*)(lds + 256 * XT_STR * 2 + 128 * XT_STR * 2);
    const size_t m0 = (size_t)cid * 64;
    if (wave < 4) { const int h = 4 * g + wave; const float dt = DT[(m0 + lane) * 8 + h]; const float a = -__expf(P.a_log[h]);
        const float cum = wave_incl_scan(dt * a, lane); const float tot = __shfl(cum, 63);
        wsc[wave * 64 + lane] = dt * __expf(tot - cum); if (lane == 63) CDEC[cid * 8 + h] = __expf(tot); }
    __syncthreads();
    { const int cg8 = tid & 31, seg = tid >> 5, t0 = 4 * seg; float o[4][8];
        conv8x4(P, PROJ, cid, PC_XS + 256 * g + 8 * cg8, 256 * g + 8 * cg8, t0, o);
        const int hh = cg8 >> 3; const f32x4 w4 = *(const LAS f32x4*)(wsc + hh * 64 + t0);
#pragma unroll
        for (int e = 0; e < 8; ++e) { u32x2 w; w.x = pk2(o[0][e] * w4[0], o[1][e] * w4[1]); w.y = pk2(o[2][e] * w4[2], o[3][e] * w4[3]); *(LAS u32x2*)(xsT + (8 * cg8 + e) * XT_STR + t0) = w; } }
    if (tid < 256) { const int cg8 = tid & 15, seg = tid >> 4, t0 = 4 * seg; float o[4][8];
        conv8x4(P, PROJ, cid, PC_B + 128 * g + 8 * cg8, 512 + 128 * g + 8 * cg8, t0, o);
#pragma unroll
        for (int e = 0; e < 8; ++e) { u32x2 w; w.x = pk2(o[0][e], o[1][e]); w.y = pk2(o[2][e], o[3][e]); *(LAS u32x2*)(BmT + (8 * cg8 + e) * XT_STR + t0) = w; } }
    __syncthreads();
    const int hh = wave >> 1, ph = wave & 1, h = 4 * g + hh, fr = lane & 15, fq = lane >> 4;
    f32x4 acc[2][8];
#pragma unroll
    for (int pt = 0; pt < 2; ++pt)
#pragma unroll
        for (int nt = 0; nt < 8; ++nt) acc[pt][nt] = (f32x4){0.f, 0.f, 0.f, 0.f};
#pragma unroll
    for (int ks = 0; ks < 2; ++ks) { bf16x8 a[2];
#pragma unroll
        for (int pt = 0; pt < 2; ++pt) a[pt] = *(const LAS bf16x8*)(xsT + (64 * hh + 32 * ph + 16 * pt + fr) * XT_STR + 32 * ks + 8 * fq);
#pragma unroll
        for (int nt = 0; nt < 8; ++nt) { const bf16x8 b = *(const LAS bf16x8*)(BmT + (16 * nt + fr) * XT_STR + 32 * ks + 8 * fq);
#pragma unroll
            for (int pt = 0; pt < 2; ++pt) acc[pt][nt] = __builtin_amdgcn_mfma_f32_16x16x32_bf16(b, a[pt], acc[pt][nt], 0, 0, 0); } }
    float* bp = BST + ((size_t)cid * 8 + h) * 8192;
#pragma unroll
    for (int pt = 0; pt < 2; ++pt)
#pragma unroll
        for (int nt = 0; nt < 8; ++nt)
            *(f32x4*)(bp + (32 * ph + 16 * pt + fr) * 128 + 16 * nt + 4 * fq) = acc[pt][nt];
    __syncthreads();
}

__device__ __forceinline__ void p3_scan(const Params& P, int tid, int G) {
    asm volatile("" : "+v"(tid));
    const float* CDEC = (const float*)(P.ws + WS_CDEC); const float* BST = (const float*)(P.ws + WS_BSTATE); bf16* SPV = (bf16*)(P.ws + WS_SPREV); const bf16* PROJ = (const bf16*)(P.ws + WS_PROJ);
    const int gt = blockIdx.x * NTHREADS + tid, NT = G * NTHREADS;
    for (int item = gt; item < 131072; item += NT) { const int b = item >> 14, e = item & 16383, h = e >> 11; const size_t eo = (size_t)e * 4;
        f32x4 s = (f32x4){0.f, 0.f, 0.f, 0.f};
        for (int c0 = 0; c0 < 64; c0 += 8) { f32x4 bs[8]; float dc[8];
#pragma unroll
            for (int u = 0; u < 8; ++u) { const size_t cid = (size_t)b * 64 + c0 + u; bs[u] = *(const f32x4*)(BST + cid * 65536 + eo); dc[u] = CDEC[cid * 8 + h]; }
#pragma unroll
            for (int u = 0; u < 8; ++u) { const size_t cid = (size_t)b * 64 + c0 + u; u32x2 w; w.x = pk2(s[0], s[1]); w.y = pk2(s[2], s[3]); *(u32x2*)(SPV + cid * 65536 + eo) = w; s = s * dc[u] + bs[u]; } }
        *(f32x4*)(P.out + O_SSMP + (size_t)b * 65536 + eo) = s;
        { const size_t cid = NCH_P + b; const f32x4 s0 = *(const f32x4*)(P.state_ssm + (size_t)b * 65536 + eo); u32x2 w; w.x = pk2(s0[0], s0[1]); w.y = pk2(s0[2], s0[3]); *(u32x2*)(SPV + cid * 65536 + eo) = w;
            *(f32x4*)(P.out + O_SSMS + (size_t)b * 65536 + eo) = s0 * CDEC[cid * 8 + h] + *(const f32x4*)(BST + cid * 65536 + eo); } }
    for (int i = gt; i < 24576; i += NT) { const int b = i / 3072, r = (i / 1024) % 3, ch = i & 1023;
        P.out[O_CONVP + i] = bf2f(PROJ[((size_t)b * SEQ + SEQ - 3 + r) * NPROJ + PC_XS + ch]);
        P.out[O_CONVS + i] = bf2f(PROJ[((size_t)MP + b * 64 + 61 + r) * NPROJ + PC_XS + ch]); }
    for (int i = gt; i < 131072; i += NT) { const int b = i >> 14, j = (i >> 7) & 127, kd = i & 127;
        const size_t rp = ((size_t)b * SEQ + SEQ - 128 + j) * NPROJ;
        P.out[O_KP + i] = bf2f(PROJ[rp + PC_K + kd]); P.out[O_VP + i] = bf2f(PROJ[rp + PC_V + kd]);
        if (j < 64) { const size_t o = ((size_t)b * 128 + j + 64) * 128 + kd; P.out[O_KS + i] = P.cache_k[o]; P.out[O_VS + i] = P.cache_v[o]; }
        else { const size_t rs = ((size_t)MP + b * 64 + j - 64) * NPROJ; P.out[O_KS + i] = bf2f(PROJ[rs + PC_K + kd]); P.out[O_VS + i] = bf2f(PROJ[rs + PC_V + kd]); } }
}

constexpr int YT_STR = 260;
__device__ __forceinline__ void ssd_unit(const Params& P, LAS unsigned char* lds, int cid, int g, int tid, int lane, int wave) {
    asm volatile("" : "+v"(tid), "+v"(lane));
    const bf16* PROJ = (const bf16*)(P.ws + WS_PROJ); const float* DT = (const float*)(P.ws + WS_DT); const bf16* SPV = (const bf16*)(P.ws + WS_SPREV); bf16* MIXED = (bf16*)(P.ws + WS_MIXED);
    LAS bf16* xsT = (LAS bf16*)lds;
    LAS bf16* Bm = (LAS bf16*)(lds + 36864);
    LAS bf16* Cm = (LAS bf16*)(lds + 36864 + 17408);
    LAS float* CB = (LAS float*)(lds + 36864 + 2 * 17408);
    LAS float* dts = (LAS float*)(lds + 36864 + 3 * 17408);
    LAS float* cums = dts + 256;
    LAS float* yt = (LAS float*)lds;
    const size_t m0 = (size_t)cid * 64;
    const int fr = lane & 15, fq = lane >> 4, hh = wave >> 1, ph = wave & 1, h = 4 * g + hh;
    bf16x8 sb[2][4]; { const bf16* sp = SPV + (((size_t)cid * 8 + h) * 64 + 32 * ph + fr) * 128 + 8 * fq;
#pragma unroll
        for (int pt = 0; pt < 2; ++pt)
#pragma unroll
            for (int ks = 0; ks < 4; ++ks) sb[pt][ks] = *(const bf16x8*)(sp + (size_t)pt * 16 * 128 + 32 * ks); }
    u32x2 zw8[8];
#pragma unroll
    for (int q = 0; q < 8; ++q) zw8[q] = *(const u32x2*)(PROJ + (m0 + 8 * wave + q) * NPROJ + PC_Z + 256 * g + 4 * lane);
    if (wave < 4) { const int h2 = 4 * g + wave; const float dt = DT[(m0 + lane) * 8 + h2]; const float a = -__expf(P.a_log[h2]);
        const float cum = wave_incl_scan(dt * a, lane); dts[wave * 64 + lane] = dt; cums[wave * 64 + lane] = cum; }
    { const int cg8 = tid & 31, seg = tid >> 5, t0 = 4 * seg; float o[4][8];
        conv8x4(P, PROJ, cid, PC_XS + 256 * g + 8 * cg8, 256 * g + 8 * cg8, t0, o);
#pragma unroll
        for (int e = 0; e < 8; ++e) { u32x2 w; w.x = pk2(o[0][e], o[1][e]); w.y = pk2(o[2][e], o[3][e]); *(LAS u32x2*)(xsT + (8 * cg8 + e) * XT_STR + t0) = w; }
        const int isC = cg8 >> 4, c16 = cg8 & 15;
        conv8x4(P, PROJ, cid, (isC ? PC_C : PC_B) + 128 * g + 8 * c16, (isC ? 768 : 512) + 128 * g + 8 * c16, t0, o);
        LAS bf16* dst = isC ? Cm : Bm;
#pragma unroll
        for (int tt = 0; tt < 4; ++tt) { u32x4 w; w.x = pk2(o[tt][0], o[tt][1]); w.y = pk2(o[tt][2], o[tt][3]); w.z = pk2(o[tt][4], o[tt][5]); w.w = pk2(o[tt][6], o[tt][7]); *(LAS u32x4*)(dst + (t0 + tt) * BM_STR + 8 * c16) = w; } }
    __syncthreads();
    { const int lt = wave >> 1, st0 = 2 * (wave & 1); f32x4 ca[2] = {(f32x4){0.f, 0.f, 0.f, 0.f}, (f32x4){0.f, 0.f, 0.f, 0.f}};
#pragma unroll
        for (int ks = 0; ks < 4; ++ks) { const bf16x8 a = *(const LAS bf16x8*)(Cm + (16 * lt + fr) * BM_STR + 32 * ks + 8 * fq);
#pragma unroll
            for (int u = 0; u < 2; ++u) { const bf16x8 b = *(const LAS bf16x8*)(Bm + (16 * (st0 + u) + fr) * BM_STR + 32 * ks + 8 * fq); ca[u] = __builtin_amdgcn_mfma_f32_16x16x32_bf16(a, b, ca[u], 0, 0, 0); } }
#pragma unroll
        for (int u = 0; u < 2; ++u)
#pragma unroll
            for (int i = 0; i < 4; ++i) CB[(16 * lt + 4 * fq + i) * CB_STR + 16 * (st0 + u) + fr] = ca[u][i]; }
    __syncthreads();
    f32x4 acc[4][2];
#pragma unroll
    for (int lt = 0; lt < 4; ++lt)
#pragma unroll
        for (int pt = 0; pt < 2; ++pt) acc[lt][pt] = (f32x4){0.f, 0.f, 0.f, 0.f};
    {
#pragma unroll
        for (int lt = 0; lt < 4; ++lt)
#pragma unroll
            for (int ks = 0; ks < 4; ++ks) { const bf16x8 a = *(const LAS bf16x8*)(Cm + (16 * lt + fr) * BM_STR + 32 * ks + 8 * fq);
#pragma unroll
                for (int pt = 0; pt < 2; ++pt) acc[lt][pt] = __builtin_amdgcn_mfma_f32_16x16x32_bf16(a, sb[pt][ks], acc[lt][pt], 0, 0, 0); }
#pragma unroll
        for (int lt = 0; lt < 4; ++lt) { const f32x4 c4 = *(const LAS f32x4*)(cums + hh * 64 + 16 * lt + 4 * fq);
#pragma unroll
            for (int i = 0; i < 4; ++i) { const float e = __expf(c4[i]); acc[lt][0][i] *= e; acc[lt][1][i] *= e; } }
    }
#pragma unroll
    for (int lt = 0; lt < 4; ++lt)
#pragma unroll
        for (int ks = 0; ks < 2; ++ks) { if (32 * ks > 16 * lt + 15) continue;
            const int l = 16 * lt + fr, s0 = 32 * ks + 8 * fq; const float cl = cums[hh * 64 + l];
            const f32x4 cb0 = *(const LAS f32x4*)(CB + l * CB_STR + s0), cb1 = *(const LAS f32x4*)(CB + l * CB_STR + s0 + 4);
            const f32x4 cs0 = *(const LAS f32x4*)(cums + hh * 64 + s0), cs1 = *(const LAS f32x4*)(cums + hh * 64 + s0 + 4);
            const f32x4 d0 = *(const LAS f32x4*)(dts + hh * 64 + s0), d1 = *(const LAS f32x4*)(dts + hh * 64 + s0 + 4);
            float mv[8];
#pragma unroll
            for (int j = 0; j < 4; ++j) { mv[j] = (s0 + j <= l) ? cb0[j] * __expf(fminf(cl - cs0[j], 0.f)) * d0[j] : 0.f; mv[4 + j] = (s0 + 4 + j <= l) ? cb1[j] * __expf(fminf(cl - cs1[j], 0.f)) * d1[j] : 0.f; }
            union { u32x4 u; bf16x8 v; } af; af.u.x = pk2(mv[0], mv[1]); af.u.y = pk2(mv[2], mv[3]); af.u.z = pk2(mv[4], mv[5]); af.u.w = pk2(mv[6], mv[7]);
#pragma unroll
            for (int pt = 0; pt < 2; ++pt) { const bf16x8 b = *(const LAS bf16x8*)(xsT + (64 * hh + 32 * ph + 16 * pt + fr) * XT_STR + s0); acc[lt][pt] = __builtin_amdgcn_mfma_f32_16x16x32_bf16(af.v, b, acc[lt][pt], 0, 0, 0); } }
    { const float dsk = P.d_skip[h];
#pragma unroll
        for (int lt = 0; lt < 4; ++lt)
#pragma unroll
            for (int pt = 0; pt < 2; ++pt) { const u32x2 xw = *(const LAS u32x2*)(xsT + (64 * hh + 32 * ph + 16 * pt + fr) * XT_STR + 16 * lt + 4 * fq);
                acc[lt][pt][0] += dsk * __uint_as_float(xw.x << 16); acc[lt][pt][1] += dsk * __uint_as_float(xw.x & 0xffff0000u); acc[lt][pt][2] += dsk * __uint_as_float(xw.y << 16); acc[lt][pt][3] += dsk * __uint_as_float(xw.y & 0xffff0000u); } }
    __syncthreads();
#pragma unroll
    for (int lt = 0; lt < 4; ++lt)
#pragma unroll
        for (int pt = 0; pt < 2; ++pt)
#pragma unroll
            for (int i = 0; i < 4; ++i) yt[(16 * lt + 4 * fq + i) * YT_STR + 64 * hh + 32 * ph + 16 * pt + fr] = acc[lt][pt][i];
    __syncthreads();
    const f32x4 nw = *(const f32x4*)(P.ssm_norm_w + 256 * g + 4 * lane);
#pragma unroll
    for (int q = 0; q < 8; ++q) { const int l = 8 * wave + q; const f32x4 y = *(const LAS f32x4*)(yt + l * YT_STR + 4 * lane);
        const u32x2 zw = zw8[q];
        f32x4 gg; gg[0] = y[0] * silu_f(__uint_as_float(zw.x << 16)); gg[1] = y[1] * silu_f(__uint_as_float(zw.x & 0xffff0000u)); gg[2] = y[2] * silu_f(__uint_as_float(zw.y << 16)); gg[3] = y[3] * silu_f(__uint_as_float(zw.y & 0xffff0000u));
        const float ss = wave_sum(gg[0] * gg[0] + gg[1] * gg[1] + gg[2] * gg[2] + gg[3] * gg[3]); const float rs = 1.0f / sqrtf(ss * (1.0f / 256.0f) + RMS_EPS);
        u32x2 w; w.x = pk2(gg[0] * rs * nw[0], gg[1] * rs * nw[1]); w.y = pk2(gg[2] * rs * nw[2], gg[3] * rs * nw[3]);
        *(u32x2*)(MIXED + (m0 + l) * DM + 256 * g + 4 * lane) = w; }
    __syncthreads();
}

__device__ __forceinline__ void ln_rows(const bf16* in, const float* gam, const float* bet, bf16* obf, float* of32, const float* part, int nparts, const float* xs, const bf16* hb, int lane, int wave, int G) {
    asm volatile("" : "+v"(lane));
    const int gw = blockIdx.x * NWAVES + wave, NGW = G * NWAVES;
    f32x4 gv[4], bv[4];
#pragma unroll
    for (int j = 0; j < 4; ++j) { gv[j] = *(const f32x4*)(gam + 4 * lane + 256 * j); bv[j] = *(const f32x4*)(bet + 4 * lane + 256 * j); }
    for (int m = gw; m < M; m += NGW) {
        f32x4 v[4]; float s = 0.f;
        if (m < MP) { const bf16* xr = in + (size_t)m * DM + 4 * lane;
#pragma unroll
            for (int j = 0; j < 4; ++j) { const u32x2 hw = *(const u32x2*)(xr + 256 * j); v[j][0] = __uint_as_float(hw.x << 16); v[j][1] = __uint_as_float(hw.x & 0xffff0000u); v[j][2] = __uint_as_float(hw.y << 16); v[j][3] = __uint_as_float(hw.y & 0xffff0000u); } }
        else { const size_t ro = (size_t)(m - MP) * DM + 4 * lane;
#pragma unroll
            for (int j = 0; j < 4; ++j) { if (xs) v[j] = *(const f32x4*)(xs + ro + 256 * j) * ALPHA;
                else { const u32x2 hw = *(const u32x2*)(hb + (size_t)m * DM + 4 * lane + 256 * j); v[j][0] = ALPHA * __uint_as_float(hw.x << 16); v[j][1] = ALPHA * __uint_as_float(hw.x & 0xffff0000u); v[j][2] = ALPHA * __uint_as_float(hw.y << 16); v[j][3] = ALPHA * __uint_as_float(hw.y & 0xffff0000u); } }
            for (int sp = 0; sp < nparts; ++sp) { const float* pr = part + (size_t)sp * MS * DM + ro;
#pragma unroll
                for (int j = 0; j < 4; ++j) v[j] = v[j] + *(const f32x4*)(pr + 256 * j); } }
#pragma unroll
        for (int j = 0; j < 4; ++j) s += (v[j][0] + v[j][1]) + (v[j][2] + v[j][3]);
        const float mean = wave_sum(s) * (1.f / DM); float s2 = 0.f;
#pragma unroll
        for (int j = 0; j < 4; ++j) { v[j] = v[j] - mean; s2 += (v[j][0] * v[j][0] + v[j][1] * v[j][1]) + (v[j][2] * v[j][2] + v[j][3] * v[j][3]); }
        const float rstd = 1.f / sqrtf(wave_sum(s2) * (1.f / DM) + LN_EPS);
#pragma unroll
        for (int j = 0; j < 4; ++j) { const f32x4 o = v[j] * rstd * gv[j] + bv[j];
            if (obf) { u32x2 w; w.x = pk2(o[0], o[1]); w.y = pk2(o[2], o[3]); *(u32x2*)(obf + (size_t)m * DM + 4 * lane + 256 * j) = w; }
            if (of32) *(f32x4*)(of32 + (size_t)m * DM + 4 * lane + 256 * j) = o; } }
}

#define RLX_AGENT __ATOMIC_RELAXED, __HIP_MEMORY_SCOPE_AGENT
#define XB_TMO      128
#define XB_XCNT(j)  (256  + 64 * (j))
#define XB_XSUB(j)  (1280 + 64 * (j))
#define XB_XGEN(j)  (2304 + 64 * (j))
#define XB_TOP      3328
#define XB_TOPGEN   3392
#define XCD_BAR_WORDS 3456
#define XB_SPIN_CAP (1u << 18)

__device__ __forceinline__ unsigned xb_ld(unsigned* p)              { return __hip_atomic_load(p, __ATOMIC_RELAXED, __HIP_MEMORY_SCOPE_AGENT); }
__device__ __forceinline__ unsigned xb_add(unsigned* p, unsigned v) { return __hip_atomic_fetch_add(p, v, __ATOMIC_RELAXED, __HIP_MEMORY_SCOPE_AGENT); }
__device__ __forceinline__ unsigned xb_xcc_id() { return (unsigned)__builtin_amdgcn_s_getreg((3 << 11) | 20) & 0xFu; }
#define XB_SPIN(cond, bar) do { unsigned _sp = 0; while (cond) { __builtin_amdgcn_s_sleep(1); \
    if ((++_sp & 255u) == 0u) { if (xb_ld(&(bar)[XB_TMO])) break; if (_sp > XB_SPIN_CAP) { atomicAdd(&(bar)[XB_TMO], 1u); break; } } } } while (0)

struct XcdBarrier {
    unsigned* bar; unsigned x;
    volatile LAS unsigned* st;
};

__device__ __forceinline__ XcdBarrier xcd_barrier_post(unsigned* bar, volatile LAS unsigned* st) {
    XcdBarrier b; b.bar = bar; b.x = xb_xcc_id(); b.st = st;
    if (threadIdx.x == 0) (void)xb_add(&bar[XB_XCNT(b.x)], 1u);
    return b;
}
__device__ __forceinline__ void xcd_barrier_complete(unsigned* bar, unsigned x, unsigned& nloc, unsigned& nx) {
    const unsigned G = gridDim.x * gridDim.y * gridDim.z;
    unsigned sum, cnt, mine, sp = 0u;
    for (;;) {
        sum = 0u; cnt = 0u; mine = 0u;
#pragma unroll
        for (unsigned j = 0; j < 16; ++j) { const unsigned c = xb_ld(&bar[XB_XCNT(j)]); sum += c; cnt += (c > 0u) ? 1u : 0u; mine = (j == x) ? c : mine; }
        if (sum == G) break;
        __builtin_amdgcn_s_sleep(1);
        if ((++sp & 255u) == 0u) { if (xb_ld(&bar[XB_TMO])) break; if (sp > XB_SPIN_CAP) { atomicAdd(&bar[XB_TMO], 1u); break; } }
    }
    nloc = mine > 0u ? mine : 1u; nx = cnt > 0u ? cnt : 1u;
}

__device__ __forceinline__ void xcd_barrier(const XcdBarrier& b) {
    asm volatile("s_waitcnt vmcnt(0)" ::: "memory");
    __syncthreads();
    if (threadIdx.x == 0) {
        unsigned* bar = b.bar;
        __builtin_amdgcn_s_waitcnt(0);
        unsigned nloc = b.st[0], nx = b.st[1];
        if (nloc == 0u) { xcd_barrier_complete(bar, b.x, nloc, nx); b.st[0] = nloc; b.st[1] = nx; }
        const unsigned old = xb_add(&bar[XB_XSUB(b.x)], 1u);
        const unsigned gen = old / nloc;
        if (old + 1u == (gen + 1u) * nloc) {
            __builtin_amdgcn_fence(__ATOMIC_RELEASE, "agent");
            asm volatile("s_waitcnt vmcnt(0)" ::: "memory");
            const unsigned og = xb_add(&bar[XB_TOP], 1u);
            const unsigned tg = og / nx;
            if (og + 1u == (tg + 1u) * nx) xb_add(&bar[XB_TOPGEN], 1u);
            else XB_SPIN(xb_ld(&bar[XB_TOPGEN]) == tg, bar);
            __builtin_amdgcn_fence(__ATOMIC_ACQUIRE, "agent");
            xb_add(&bar[XB_XGEN(b.x)], 1u);
            asm volatile("s_waitcnt vmcnt(0)" ::: "memory");
        } else {
            XB_SPIN(xb_ld(&bar[XB_XGEN(b.x)]) == gen, bar);
            __builtin_amdgcn_fence(__ATOMIC_ACQUIRE, "agent");
            asm volatile("s_waitcnt vmcnt(0)" ::: "memory");
        }
    }
    __syncthreads();
}
#ifndef PHMASK
#define PHMASK 0x3ff
#endif
#define PH(n) ((PHMASK >> (n)) & 1)
#ifndef DBLMASK
#define DBLMASK 0
#define DYNQ 1
#endif
#define REP(n) for (int rep_ = 0; rep_ < 1 + ((DBLMASK >> (n)) & 1); ++rep_)
__global__ void __launch_bounds__(NTHREADS, 2) hymba_fwd(Params P) {
    extern __shared__ __attribute__((aligned(16))) unsigned char lds_raw[];
    LAS unsigned char* lds = (LAS unsigned char*)lds_raw;
    cg::grid_group grid = cg::this_grid();
    const int tid = threadIdx.x, lane = tid & 63, wave = __builtin_amdgcn_readfirstlane(tid >> 6), G = gridDim.x;
    unsigned char* ws = P.ws;
    if (G == 0x7fffffff) grid.sync();
    volatile LAS unsigned* bst = (volatile LAS unsigned*)(lds + 131072);
    if (tid < 2) bst[tid] = 0u;
    __syncthreads();
    const XcdBarrier xbar = xcd_barrier_post((unsigned*)ws, bst);
#define GSYNC() xcd_barrier(xbar)
    bf16* WIN = (bf16*)(ws + WS_WIN); bf16* WOUT = (bf16*)(ws + WS_WOUT); bf16* WGU = (bf16*)(ws + WS_WGU); bf16* WDN = (bf16*)(ws + WS_WDN);
    bf16* XB = (bf16*)(ws + WS_XB); bf16* PROJ = (bf16*)(ws + WS_PROJ); bf16* MIXED = (bf16*)(ws + WS_MIXED); bf16* HB = (bf16*)(ws + WS_H); bf16* ACT = (bf16*)(ws + WS_ACT);

#if PH(0)
    REP(0) p0_prologue(P, lds, tid, lane, wave, G);
#endif
    GSYNC();
#if PH(1)
    REP(1) {
        pg8::Gemm g{XB, WIN, M, NPROJ, DM, DM}; pg8::StaticOrder S; S.init(M, NPROJ, G, (int)blockIdx.x);
        pg8::EpiBf16<0> E{PROJ, NPROJ, nullptr, 0, 0, 1.f};
        pg8::gemm_phase<pg8::EpiBf16<0>, pg8::StaticOrder, true, true>(lds, g, S, E);
    }
    GSYNC();
#endif
#if PH(2)
    {
        volatile LAS int* qs = (volatile LAS int*)(lds + 131072 + 64); unsigned* qc = (unsigned*)ws + 3520; int it = 0;
        for (int u = blockIdx.x; u < NATT2 + 2 * NCH; ++it) {
#ifdef DYNQ
            if (tid == 0) qs[it & 1] = G + (int)atomicAdd(qc, 1u);
#endif
            if (u < NATT2) attn_unit(P, lds, u >> 1, u & 1, tid, lane, wave); else { const int v = u - NATT2; bstate_unit(P, lds, v >> 1, v & 1, tid, lane, wave); }
#ifdef DYNQ
            u = __builtin_amdgcn_readfirstlane(qs[it & 1]);
#else
            u += G;
#endif
            }
    }
    GSYNC();
#endif
#if PH(3)
    REP(3) p3_scan(P, tid, G);
#ifdef XSYNC
    for (int xs_ = 0; xs_ < XSYNC; ++xs_) GSYNC();
#endif
#endif
    GSYNC();
#if PH(4)
    {
        volatile LAS int* qs = (volatile LAS int*)(lds + 131072 + 64); unsigned* qc = (unsigned*)ws + 3584; int it = 0;
        for (int u = blockIdx.x; u < 2 * NCH + (2 * NCH - NATT2); ++it) {
#ifdef DYNQ
            if (tid == 0) qs[it & 1] = G + (int)atomicAdd(qc, 1u);
#endif
            if (u < 2 * NCH) ssd_unit(P, lds, u >> 1, u & 1, tid, lane, wave); else { const int v = NATT2 + (u - 2 * NCH); attn_unit(P, lds, v >> 1, v & 1, tid, lane, wave); }
#ifdef DYNQ
            u = __builtin_amdgcn_readfirstlane(qs[it & 1]);
#else
            u += G;
#endif
            }
    }
    GSYNC();
#endif
#if PH(5)
    REP(5) {
        pg8::Gemm g{MIXED, WOUT, M, DM, DM, DM}; pg8::StaticOrder S; S.init(MP, DM, G, (int)blockIdx.x);
        pg8::EpiResBf16 E{P.x_prompt, nullptr, (bf16*)(ws + WS_PRE1), DM, ALPHA};
        pg8::gemm_phase<pg8::EpiResBf16, pg8::StaticOrder, true, true>(lds, g, S, E);
        pg8::Gemm gt{MIXED, WOUT, M, DM, DM, 256}; pg8::TailOrder T{MP / 256, 32, 4, 256, G, (int)((blockIdx.x + 128) % G)};
        pg8::EpiPartF32 Et{(float*)(ws + WS_PART), DM, MP, MS, 256};
        pg8::gemm_phase<pg8::EpiPartF32, pg8::TailOrder, false, true>(lds, gt, T, Et);
    }
    GSYNC();
#endif
#if PH(6)
    REP(6) ln_rows((const bf16*)(ws + WS_PRE1), P.ln1_g, P.ln1_b, HB, nullptr, (const float*)(ws + WS_PART), 4, P.x_sample, nullptr, lane, wave, G);
    GSYNC();
#endif
#if PH(7)
    REP(7) {
        pg8::Gemm g{HB, WGU, M, NGU, DM, DM}; pg8::StaticOrder S; S.init(M, NGU, G, (int)blockIdx.x);
        pg8::EpiSwiglu E{ACT, DFF};
        pg8::gemm_phase<pg8::EpiSwiglu, pg8::StaticOrder, true, true>(lds, g, S, E);
    }
    GSYNC();
#endif
#if PH(8)
    REP(8) {
        pg8::Gemm g{ACT, WDN, M, DM, DFF, DFF}; pg8::StaticOrder S; S.init(MP, DM, G, (int)blockIdx.x);
        pg8::EpiResBf16 E{nullptr, HB, (bf16*)(ws + WS_PRE2), DM, ALPHA};
        pg8::gemm_phase<pg8::EpiResBf16, pg8::StaticOrder, true, true>(lds, g, S, E);
        pg8::Gemm gt{ACT, WDN, M, DM, DFF, 256}; pg8::TailOrder T{MP / 256, 88, 11, 256, G, (int)((blockIdx.x + 128) % G)};
        pg8::EpiPartF32 Et{(float*)(ws + WS_PART), DM, MP, MS, 256};
        pg8::gemm_phase<pg8::EpiPartF32, pg8::TailOrder, false, true>(lds, gt, T, Et);
    }
    GSYNC();
#endif
#if PH(9)
    ln_rows((const bf16*)(ws + WS_PRE2), P.ln2_g, P.ln2_b, nullptr, P.out + O_Y, (const float*)(ws + WS_PART), 11, nullptr, HB, lane, wave, G);
#endif
}

extern "C" void kernel_launch(void* const* d_in, const int* in_sizes, int n_in, void* d_out, int out_size, void* d_ws, size_t ws_size, hipStream_t stream) {
    static int grid = 0;
    if (grid == 0) {
        if (n_in != 22 || (size_t)out_size != O_END || ws_size < WS_END) { fprintf(stderr, "kernel_launch: unexpected shapes: n_in %d out %d ws %zu (need %zu)\n", n_in, out_size, ws_size, (size_t)WS_END); grid = -1; return; }
        int dev = 0, cus = 0, per_cu = 0;
        hipGetDevice(&dev); hipDeviceGetAttribute(&cus, hipDeviceAttributeMultiprocessorCount, dev);
        hipFuncSetAttribute((const void*)hymba_fwd, hipFuncAttributeMaxDynamicSharedMemorySize, LDS_BYTES);
        hipOccupancyMaxActiveBlocksPerMultiprocessor(&per_cu, (const void*)hymba_fwd, NTHREADS, LDS_BYTES);
        if (per_cu < 1) { fprintf(stderr, "kernel_launch: occupancy query says %d blocks/CU\n", per_cu); per_cu = 1; }
        grid = cus * per_cu;
    }
    if (grid < 0) return;
    Params p{};
    const float** pp = (const float**)&p;
    for (int i = 0; i < 22; ++i) pp[i] = (const float*)d_in[i];
    p.out = (float*)d_out; p.ws = (unsigned char*)d_ws;
    if (hipMemsetAsync(d_ws, 0, 16384, stream) != hipSuccess) { fprintf(stderr, "memset failed\n"); return; }
    void* args[] = {&p};
    hipError_t e = hipLaunchCooperativeKernel((const void*)hymba_fwd, dim3(grid), dim3(NTHREADS), args, LDS_BYTES, stream);
    if (e != hipSuccess) fprintf(stderr, "cooperative launch failed: %s (grid %d)\n", hipGetErrorString(e), grid);
}
```
